# Optimizing an MI355X kernel written in HIP

```python
import jax
import jax.numpy as jnp
from jax import lax
import numpy as np

D_MODEL = 2048
BATCH = 2
SEQ = 4096
DEPTH = 1

GRID_W = 64
CTX_LEN = 256
RET_HEADS = 8
RET_DK = 128
RET_DV = 256
RET_QK_W = RET_HEADS * RET_DK
RET_V_W = RET_HEADS * RET_DV
CHUNK = 128
POOL_WINDOWS = (2, 4, 8, 16)
POOL_GROUPS = len(POOL_WINDOWS)
POOL_GW = 256
POOL_W = POOL_GROUPS * POOL_GW
D_FF = 5632
ROPE_BASE = 10000.0
NORM_EPS = 1e-6
GN_EPS = 1e-5
N_MOD = 9
COL_K = 0
COL_V = COL_K + RET_QK_W
COL_Q = COL_V + RET_V_W
COL_G = COL_Q + RET_QK_W
COL_P = COL_G + RET_V_W
IN_W = COL_P + POOL_W
KV_W = COL_Q

kernel_name = 'hybrid_retention_pool_dit_layer'


def _rmsnorm(x, g):
    xf = x.astype(jnp.float32)
    y = xf * lax.rsqrt(jnp.mean(xf * xf, axis=-1, keepdims=True) + NORM_EPS)
    return (y * g.astype(jnp.float32)).astype(x.dtype)


def _modulate(x, shift, scale):
    return x * (1 + scale) + shift


def _swiglu(x, w13, w2):
    a, b = jnp.split(x @ w13, 2, axis=-1)
    return (jax.nn.silu(a) * b) @ w2


def _rotate(x, pos):
    d = x.shape[-1]
    inv = ROPE_BASE ** (-jnp.arange(0, d, 2, dtype=jnp.float32) / d)
    ang = pos.astype(jnp.float32)[:, None] * inv[None, :]
    cos = jnp.cos(ang)[None, :, None, :]
    sin = jnp.sin(ang)[None, :, None, :]
    x1, x2 = x[..., : d // 2], x[..., d // 2:]
    return jnp.concatenate([x1 * cos - x2 * sin, x1 * sin + x2 * cos], axis=-1)


def _rope_2d(x):
    L = x.shape[1]
    ROWS = L // GRID_W
    rows = jnp.repeat(jnp.arange(ROWS), GRID_W)
    cols = jnp.tile(jnp.arange(GRID_W), ROWS)
    half = x.shape[-1] // 2
    return jnp.concatenate([_rotate(x[..., :half], rows), _rotate(x[..., half:], cols)], axis=-1)


def _retention_chunks(q, k, v, log_g, s0):
    B, L, H, _ = q.shape
    DV = v.shape[-1]
    n = L // CHUNK

    def blocks(t):
        return t.reshape(B, n, CHUNK, H, t.shape[-1]).transpose(1, 0, 2, 3, 4)

    idx = jnp.arange(CHUNK, dtype=jnp.float32)
    rel = idx[:, None] - idx[None, :]
    decay_mat = jnp.where(rel >= 0, jnp.exp(log_g[:, None, None] * jnp.maximum(rel, 0.0)), 0.0)
    q_dec = jnp.exp(log_g[None, :] * (idx[:, None] + 1.0))
    k_dec = jnp.exp(log_g[None, :] * (CHUNK - 1.0 - idx[:, None]))
    chunk_dec = jnp.exp(log_g * CHUNK)

    def step(S, blk):
        qb, kb, vb = blk
        scores = jnp.einsum('bihd,bjhd->bhij', qb, kb) * decay_mat[None]
        inner = jnp.einsum('bhij,bjhe->bihe', scores, vb)
        cross = jnp.einsum('bihd,bhde->bihe', qb * q_dec[None, :, :, None], S)
        S_new = S * chunk_dec[None, :, None, None] + jnp.einsum('bjhd,bjhe->bhde', kb * k_dec[None, :, :, None], vb)
        return S_new, inner + cross

    s_final, out = lax.scan(step, s0, (blocks(q), blocks(k), blocks(v)))
    return out.transpose(1, 0, 2, 3, 4).reshape(B, L, H, DV), s_final


def _retention_final_state(k, v, log_g):
    L = k.shape[1]
    w = jnp.exp(log_g[None, :] * (L - 1.0 - jnp.arange(L, dtype=jnp.float32))[:, None])
    return jnp.einsum('bjhd,bjhe->bhde', k * w[None, :, :, None], v)


def _multiscale_pool(p, pool_w, pool_scale):
    B, L, _ = p.shape
    pf = p.astype(jnp.float32)
    cs = jnp.concatenate([jnp.zeros((B, 1, POOL_W), jnp.float32), jnp.cumsum(pf, axis=1)], axis=1)
    t = jnp.arange(L)
    groups = []
    for gi, win in enumerate(POOL_WINDOWS):
        lo, hi = win // 2, win - 1 - win // 2
        start = jnp.clip(t - lo, 0, L)
        end = jnp.clip(t + hi + 1, 0, L)
        sl = slice(gi * POOL_GW, (gi + 1) * POOL_GW)
        seg = cs[:, :, sl]
        count = (end - start).astype(jnp.float32)[None, :, None]
        groups.append((seg[:, end] - seg[:, start]) / count - pf[:, :, sl])
    pooled = jnp.stack(groups, axis=2)
    mixed = jnp.einsum('blgc,gcd->blgd', pooled, pool_w.astype(jnp.float32)).reshape(B, L, POOL_W)
    return (mixed * pool_scale.astype(jnp.float32)).astype(p.dtype)


def _heads(p, lo, hi, d):
    return p[..., lo:hi].reshape(p.shape[0], p.shape[1], RET_HEADS, d).astype(jnp.float32)


def _merge(u, o, gate_in, pool_in, pool_w, pool_scale, w_out_a, w_out_b, w_gate, b_gate, w_out):
    B, L = u.shape[:2]
    mu = jnp.mean(o, axis=-1, keepdims=True)
    var = jnp.mean(jnp.square(o - mu), axis=-1, keepdims=True)
    on = ((o - mu) * lax.rsqrt(var + GN_EPS)).reshape(B, L, RET_V_W).astype(u.dtype)
    y_a = (jax.nn.silu(gate_in) * on) @ w_out_a
    y_b = _multiscale_pool(pool_in, pool_w, pool_scale) @ w_out_b
    g_a, g_b = jnp.split(jax.nn.sigmoid(u @ w_gate + b_gate), 2, axis=-1)
    return (g_a * y_a + g_b * y_b) @ w_out


def _layer(h, hc, mod, mod_c, need_ctx_out, norm_g, ffn1_w13, ffn1_w2, ffn2_w13, ffn2_w2,
           w_in, decay_logit, pool_w, pool_scale, w_out_a, w_out_b, w_gate, b_gate, w_out):
    sh1, sc1, g1, sh2, sc2, g2, sh3, sc3, g3 = jnp.split(mod, N_MOD, axis=-1)
    ch1, cs1, cg1, ch2, cs2, cg2, ch3, cs3, cg3 = jnp.split(mod_c, N_MOD, axis=-1)
    h = h + 0.5 * g1 * _swiglu(_modulate(_rmsnorm(h, norm_g[0]), sh1, sc1), ffn1_w13, ffn1_w2)
    hc = hc + 0.5 * cg1 * _swiglu(_modulate(_rmsnorm(hc, norm_g[0]), ch1, cs1), ffn1_w13, ffn1_w2)
    u = _modulate(_rmsnorm(h, norm_g[1]), sh2, sc2)
    uc = _modulate(_rmsnorm(hc, norm_g[1]), ch2, cs2)
    proj = u @ w_in
    proj_c = uc @ (w_in if need_ctx_out else w_in[:, :KV_W])
    kscale = RET_DK ** -0.5
    log_gf, log_gb = jax.nn.log_sigmoid(decay_logit.astype(jnp.float32))
    kc = _heads(proj_c, COL_K, COL_V, RET_DK) * kscale
    vc = _heads(proj_c, COL_V, COL_Q, RET_DV)
    if need_ctx_out:
        qc = _heads(proj_c, COL_Q, COL_G, RET_DK)
        zero = jnp.zeros((hc.shape[0], RET_HEADS, RET_DK, RET_DV), jnp.float32)
        oc_f, s_f = _retention_chunks(qc, kc, vc, log_gf, zero)
        oc_b, s_b = _retention_chunks(qc[:, ::-1], kc[:, ::-1], vc[:, ::-1], log_gb, zero)
        oc = oc_f + oc_b[:, ::-1]
    else:
        s_f = _retention_final_state(kc, vc, log_gf)
        s_b = _retention_final_state(kc[:, ::-1], vc[:, ::-1], log_gb)
    q = _rope_2d(_heads(proj, COL_Q, COL_G, RET_DK))
    k = _rope_2d(_heads(proj, COL_K, COL_V, RET_DK)) * kscale
    v = _heads(proj, COL_V, COL_Q, RET_DV)
    o_f, _ = _retention_chunks(q, k, v, log_gf, s_f)
    o_b, _ = _retention_chunks(q[:, ::-1], k[:, ::-1], v[:, ::-1], log_gb, s_b)
    o = o_f + o_b[:, ::-1]
    h = h + g2 * _merge(u, o, proj[..., COL_G:COL_P], proj[..., COL_P:], pool_w, pool_scale,
                        w_out_a, w_out_b, w_gate, b_gate, w_out)
    h = h + 0.5 * g3 * _swiglu(_modulate(_rmsnorm(h, norm_g[2]), sh3, sc3), ffn2_w13, ffn2_w2)
    if need_ctx_out:
        hc = hc + cg2 * _merge(uc, oc, proj_c[..., COL_G:COL_P], proj_c[..., COL_P:], pool_w, pool_scale,
                               w_out_a, w_out_b, w_gate, b_gate, w_out)
        hc = hc + 0.5 * cg3 * _swiglu(_modulate(_rmsnorm(hc, norm_g[2]), ch3, cs3), ffn2_w13, ffn2_w2)
    else:
        hc = None
    return h, hc


def setup_inputs(seed: int = 0) -> dict:
    key = jax.random.key(seed)
    ks = jax.random.split(key, 24)
    f32 = jnp.float32

    def nrm(k, shape):
        return jax.random.normal(k, shape, f32)

    def w(k, shape, fan_in, gain=1.0):
        return nrm(k, shape) * (gain * fan_in ** -0.5)

    base_logit = jnp.asarray(np.log(2.0 ** (5 + np.arange(RET_HEADS)) - 1.0).astype(np.float32))
    return {
        'x': nrm(ks[0], (BATCH, SEQ, D_MODEL)),
        'c': nrm(ks[1], (BATCH, D_MODEL)),
        'ctx': nrm(ks[2], (BATCH, CTX_LEN, D_MODEL)),
        'c_ctx': nrm(ks[3], (D_MODEL,)),
        'w_ada': w(ks[4], (DEPTH, D_MODEL, N_MOD * D_MODEL), D_MODEL, 0.5),
        'b_ada': 0.01 * nrm(ks[5], (DEPTH, N_MOD * D_MODEL)),
        'norm_g': 1.0 + 0.1 * nrm(ks[6], (DEPTH, 3, D_MODEL)),
        'ffn1_w13': w(ks[7], (DEPTH, D_MODEL, 2 * D_FF), D_MODEL),
        'ffn1_w2': w(ks[8], (DEPTH, D_FF, D_MODEL), D_FF),
        'ffn2_w13': w(ks[9], (DEPTH, D_MODEL, 2 * D_FF), D_MODEL),
        'ffn2_w2': w(ks[10], (DEPTH, D_FF, D_MODEL), D_FF),
        'w_in': w(ks[11], (DEPTH, D_MODEL, IN_W), D_MODEL),
        'decay_logit': base_logit[None, None, :] + 0.05 * nrm(ks[12], (DEPTH, 2, RET_HEADS)),
        'pool_w': w(ks[13], (DEPTH, POOL_GROUPS, POOL_GW, POOL_GW), POOL_GW),
        'pool_scale': 1.0 + 0.1 * nrm(ks[14], (DEPTH, POOL_W)),
        'w_out_a': w(ks[15], (DEPTH, RET_V_W, D_MODEL), RET_V_W),
        'w_out_b': w(ks[16], (DEPTH, POOL_W, D_MODEL), POOL_W),
        'w_gate': w(ks[17], (DEPTH, D_MODEL, 2 * D_MODEL), D_MODEL),
        'b_gate': 0.01 * nrm(ks[18], (DEPTH, 2 * D_MODEL)),
        'w_out': w(ks[19], (DEPTH, D_MODEL, D_MODEL), D_MODEL),
        'final_g': 1.0 + 0.1 * nrm(ks[20], (D_MODEL,)),
    }


def reference(x, c, ctx, c_ctx, w_ada, b_ada, norm_g, ffn1_w13, ffn1_w2, ffn2_w13, ffn2_w2,
              w_in, decay_logit, pool_w, pool_scale, w_out_a, w_out_b, w_gate, b_gate, w_out, final_g):
    h, hc = x, ctx
    for i in range(DEPTH):
        mod = (jax.nn.silu(c) @ w_ada[i] + b_ada[i])[:, None, :]
        mod_c = (jax.nn.silu(c_ctx) @ w_ada[i] + b_ada[i])[None, None, :]
        h, hc = _layer(h, hc, mod, mod_c, i < DEPTH - 1, norm_g[i], ffn1_w13[i], ffn1_w2[i],
                       ffn2_w13[i], ffn2_w2[i], w_in[i], decay_logit[i], pool_w[i], pool_scale[i],
                       w_out_a[i], w_out_b[i], w_gate[i], b_gate[i], w_out[i])
    return _rmsnorm(h, final_g)
```

```cpp
#include <hip/hip_runtime.h>
#include <hip/hip_cooperative_groups.h>
#include <cstdio>
#include <cstdint>
namespace cg = cooperative_groups;

#define LAS __attribute__((address_space(3)))
typedef unsigned short bf16_t;
typedef short bf16x8 __attribute__((ext_vector_type(8)));
typedef short s16x4 __attribute__((ext_vector_type(4)));
typedef float f32x4 __attribute__((ext_vector_type(4)));
typedef unsigned u32x4 __attribute__((ext_vector_type(4)));
typedef unsigned u32x2 __attribute__((ext_vector_type(2)));

constexpr int DM = 2048, SEQ = 4096, NLAT = 8192, NCTX = 512, MT = NLAT + NCTX, CTXL = 256;
constexpr int DFF = 5632, NMOD = 9 * DM;
constexpr int NSLOT = 34;
constexpr float LOG2E = 1.4426950408889634f;

constexpr size_t MiB = 1u << 20;
constexpr size_t WS_MOD = 0;
constexpr size_t WS_ROPE = 512 * 1024;
constexpr size_t WS_W13A = 1 * MiB, WS_W2A = 45 * MiB, WS_W13B = 67 * MiB, WS_W2B = 111 * MiB, WS_WIN = 133 * MiB;
constexpr size_t WS_WOA = 177 * MiB, WS_WOB = 185 * MiB, WS_WOUT = 189 * MiB, WS_POOLW = 197 * MiB;
constexpr size_t WS_AN = 198 * MiB;
constexpr size_t WS_H = 232 * MiB;
constexpr size_t WS_HC1 = 326 * MiB;
constexpr size_t WS_K = 330 * MiB, WS_Q = 347 * MiB, WS_V = 363 * MiB, WS_G = 397 * MiB, WS_PIN = 429 * MiB, WS_GA = 445 * MiB, WS_GB = 477 * MiB;
constexpr size_t WS_POOLED = 509 * MiB, WS_PM = 525 * MiB, WS_END = 541 * MiB;
constexpr int LDS_BYTES = 147456;

__device__ __forceinline__ unsigned f2bf(float f) { unsigned u = __builtin_bit_cast(unsigned, f); return (u + 0x7fffu + ((u >> 16) & 1u)) >> 16; }
typedef float f32x2_t __attribute__((ext_vector_type(2))); typedef __bf16 bf16x2_t __attribute__((ext_vector_type(2)));
__device__ __forceinline__ unsigned pk2(float lo, float hi) { f32x2_t v = {lo, hi}; bf16x2_t b = __builtin_convertvector(v, bf16x2_t); return __builtin_bit_cast(unsigned, b); }
__device__ __forceinline__ float bflo(unsigned w) { return __builtin_bit_cast(float, w << 16); }
__device__ __forceinline__ float bfhi(unsigned w) { return __builtin_bit_cast(float, w & 0xffff0000u); }
__device__ __forceinline__ float bf1(short s) { return __builtin_bit_cast(float, ((unsigned)(unsigned short)s) << 16); }
__device__ __forceinline__ float fsilu(float a) { return a * __builtin_amdgcn_rcpf(1.0f + __builtin_amdgcn_exp2f(-a * LOG2E)); }
__device__ __forceinline__ float fsigm(float a) { return __builtin_amdgcn_rcpf(1.0f + __builtin_amdgcn_exp2f(-a * LOG2E)); }
__device__ __forceinline__ float wave_sum(float v) {
#pragma unroll
    for (int o = 1; o < 64; o <<= 1) v += __shfl_xor(v, o);
    return v;
}

namespace pg8 {
constexpr int BM = 256, BK = 64, HALF = 128, HTB = HALF * BK * 2, STAGE_BYTES = 8 * HTB, NXCD = 8, WGM = 8;
__device__ __forceinline__ int lds_byte(int r, int c) { const int st = (r >> 4) * 2 + (c >> 5), rr = r & 15, cc = c & 31, ob = rr * 64 + cc * 2; return st * 1024 + (ob ^ (((ob >> 9) & 1) << 5)); }
__device__ __forceinline__ void stage_rc(int b, int& R, int& C) { const int st = b / 1024, sb = b % 1024, swz = sb ^ (((sb >> 9) & 1) << 5); R = (st >> 1) * 16 + swz / 64; C = (st & 1) * 32 + (swz % 64) / 2; }
__device__ __forceinline__ int perm32(int rho) { const int n = rho >> 4, i = rho & 15; return 8 * (i >> 2) + 4 * n + (i & 3); }
struct Unit { int pm, pn; };
struct Gemm { const bf16_t* A; const bf16_t* Bt; int lda, ldb, K; };

struct MixOrder {
    int nMl, nN, nLat, nNc, nCtx, G, c;
    __device__ void init(int nMl_, int nN_, int nMc_, int nNc_, int G_, int c_) { nMl = nMl_; nN = nN_; nLat = nMl_ * nN_; nNc = nNc_; nCtx = nMc_ * nNc_; G = G_; c = c_; }
    __device__ bool next(int i, Unit& u) const {
        long L = (long)i * G + c;
        if (L < nLat) {
            const int nwg = nLat, nM = nMl;
            int wgid = (int)L; { const int q = nwg / NXCD, r = nwg % NXCD, xcd = wgid % NXCD, off = wgid / NXCD; wgid = (xcd < r ? xcd * (q + 1) : r * (q + 1) + (xcd - r) * q) + off; }
            const int nig = WGM * nN, gid = wgid / nig, fm = gid * WGM, gsz = (nM - fm) < WGM ? (nM - fm) : WGM;
            u.pm = fm + ((wgid % nig) % gsz); u.pn = (wgid % nig) / gsz; return true;
        }
        L -= nLat;
        if (L < nCtx) { u.pm = nMl + (int)(L / nNc); u.pn = (int)(L % nNc); return true; }
        return false;
    }
};

__device__ __forceinline__ unsigned cvt_pk_bf16(float lo, float hi) { return pk2(lo, hi); }
__device__ __forceinline__ u32x4 pack8(const f32x4 a, const f32x4 b) { u32x4 w; w.x = cvt_pk_bf16(a[0], a[1]); w.y = cvt_pk_bf16(a[2], a[3]); w.z = cvt_pk_bf16(b[0], b[1]); w.w = cvt_pk_bf16(b[2], b[3]); return w; }

struct EpiSwiglu {
    static constexpr bool PERM = true;
    bf16_t* O; int ldc;
    __device__ __forceinline__ void operator()(const f32x4 (&acc)[2][2][4][2], const Unit& u, int wr, int wc, int fr, int fq) const {
        const int row0 = u.pm * BM + wr * 64 + fr, col0 = u.pn * HALF + wc * 32 + 8 * fq;
#pragma unroll
        for (int ai = 0; ai < 2; ++ai)
#pragma unroll
            for (int m = 0; m < 4; ++m) {
                f32x4 h0, h1;
#pragma unroll
                for (int e = 0; e < 4; ++e) { h0[e] = fsilu(acc[ai][0][m][0][e]) * acc[ai][1][m][0][e]; h1[e] = fsilu(acc[ai][0][m][1][e]) * acc[ai][1][m][1][e]; }
                *(u32x4*)(O + (size_t)(row0 + ai * HALF + m * 16) * ldc + col0) = pack8(h0, h1);
            }
    }
};
struct EpiResid {
    static constexpr bool PERM = false;
    const float* res_lat; const float* res_ctx; float* out_lat; float* out_ctx; const float* mod; int gidx; float scale;
    __device__ __forceinline__ void operator()(const f32x4 (&acc)[2][2][4][2], const Unit& u, int wr, int wc, int fr, int fq) const {
        const bool ctx = u.pm >= 32; const int bsel = ctx ? 2 : (u.pm >= 16 ? 1 : 0);
        const float* res = ctx ? res_ctx : res_lat; float* out = ctx ? out_ctx : out_lat;
        const int row0 = (ctx ? (u.pm - 32) : u.pm) * BM + wr * 64 + fr, col0 = u.pn * BM + wc * 32 + 4 * fq;
        const float* gate = mod + bsel * NMOD + gidx * DM;
        f32x4 gv[2][2];
#pragma unroll
        for (int bj = 0; bj < 2; ++bj)
#pragma unroll
            for (int n = 0; n < 2; ++n) gv[bj][n] = *(const f32x4*)(gate + col0 + bj * HALF + n * 16) * scale;
#pragma unroll
        for (int ai = 0; ai < 2; ++ai)
#pragma unroll
            for (int m = 0; m < 4; ++m) { const size_t off = (size_t)(row0 + ai * HALF + m * 16) * DM + col0;
#pragma unroll
                for (int bj = 0; bj < 2; ++bj)
#pragma unroll
                    for (int n = 0; n < 2; ++n) { const size_t o = off + bj * HALF + n * 16; const f32x4 r = *(const f32x4*)(res + o); *(f32x4*)(out + o) = r + gv[bj][n] * acc[ai][bj][m][n]; } }
    }
};
struct EpiIn {
    static constexpr bool PERM = true;
    bf16_t *K, *Q, *V, *G, *PIN, *GA, *GB; const float* bgate; const float* rope;
    __device__ __forceinline__ void operator()(const f32x4 (&acc)[2][2][4][2], const Unit& u, int wr, int wc, int fr, int fq) const {
        const int row0 = u.pm * BM + wr * 64 + fr, cb = wc * 32 + 8 * fq, pn = u.pn;
        if (pn < 4 || (pn >= 12 && pn < 16)) {
            const bool isk = pn < 4; bf16_t* dst = isk ? K : Q; const int hcol = (isk ? pn : pn - 12) * BM; const float sc = isk ? 0.08838834764831845f : 1.0f;
            const bool lat = u.pm < 32; const int i0 = (16 * wc + 4 * fq) & 31;
#pragma unroll
            for (int ai = 0; ai < 2; ++ai)
#pragma unroll
                for (int m = 0; m < 4; ++m) {
                    const int row = row0 + ai * HALF + m * 16;
                    f32x4 cs0 = {1.f, 0.f, 1.f, 0.f}, cs1 = {1.f, 0.f, 1.f, 0.f};
                    if (lat) { const int t = row & 4095; const int pos = (wc < 2) ? (t >> 6) : (t & 63); const float* rp = rope + (pos * 32 + i0) * 2; cs0 = *(const f32x4*)rp; cs1 = *(const f32x4*)(rp + 4); }
                    const float c_[4] = {cs0[0], cs0[2], cs1[0], cs1[2]}, s_[4] = {cs0[1], cs0[3], cs1[1], cs1[3]};
#pragma unroll
                    for (int bj = 0; bj < 2; ++bj) { const f32x4 x1 = acc[ai][bj][m][0], x2 = acc[ai][bj][m][1]; f32x4 o1, o2;
#pragma unroll
                        for (int e = 0; e < 4; ++e) { o1[e] = (x1[e] * c_[e] - x2[e] * s_[e]) * sc; o2[e] = (x1[e] * s_[e] + x2[e] * c_[e]) * sc; }
                        *(u32x4*)(dst + (size_t)row * 1024 + hcol + bj * HALF + cb) = pack8(o1, o2); }
                }
        } else if (pn < 12) {
#pragma unroll
            for (int ai = 0; ai < 2; ++ai)
#pragma unroll
                for (int m = 0; m < 4; ++m)
#pragma unroll
                    for (int bj = 0; bj < 2; ++bj) *(u32x4*)(V + (size_t)(row0 + ai * HALF + m * 16) * DM + (pn - 4) * BM + bj * HALF + cb) = pack8(acc[ai][bj][m][0], acc[ai][bj][m][1]);
        } else if (pn < 24) {
#pragma unroll
            for (int ai = 0; ai < 2; ++ai)
#pragma unroll
                for (int m = 0; m < 4; ++m)
#pragma unroll
                    for (int bj = 0; bj < 2; ++bj) { f32x4 a = acc[ai][bj][m][0], b = acc[ai][bj][m][1];
#pragma unroll
                        for (int e = 0; e < 4; ++e) { a[e] = fsilu(a[e]); b[e] = fsilu(b[e]); }
                        *(u32x4*)(G + (size_t)(row0 + ai * HALF + m * 16) * DM + (pn - 16) * BM + bj * HALF + cb) = pack8(a, b); }
        } else if (pn < 28) {
#pragma unroll
            for (int ai = 0; ai < 2; ++ai)
#pragma unroll
                for (int m = 0; m < 4; ++m)
#pragma unroll
                    for (int bj = 0; bj < 2; ++bj) *(u32x4*)(PIN + (size_t)(row0 + ai * HALF + m * 16) * 1024 + (pn - 24) * BM + bj * HALF + cb) = pack8(acc[ai][bj][m][0], acc[ai][bj][m][1]);
        } else {
            const int gc = (pn - 28) * BM; bf16_t* dst = gc < DM ? GA : GB; const int dc = gc < DM ? gc : gc - DM;
#pragma unroll
            for (int bj = 0; bj < 2; ++bj) { const f32x4 b0 = *(const f32x4*)(bgate + gc + bj * HALF + cb), b1 = *(const f32x4*)(bgate + gc + bj * HALF + cb + 4);
#pragma unroll
                for (int ai = 0; ai < 2; ++ai)
#pragma unroll
                    for (int m = 0; m < 4; ++m) { f32x4 a = acc[ai][bj][m][0] + b0, b = acc[ai][bj][m][1] + b1;
#pragma unroll
                        for (int e = 0; e < 4; ++e) { a[e] = fsigm(a[e]); b[e] = fsigm(b[e]); }
                        *(u32x4*)(dst + (size_t)(row0 + ai * HALF + m * 16) * DM + dc + bj * HALF + cb) = pack8(a, b); } }
        }
    }
};
struct EpiMergeA {
    static constexpr bool PERM = true;
    float* T1; const bf16_t* GA;
    __device__ __forceinline__ void operator()(const f32x4 (&acc)[2][2][4][2], const Unit& u, int wr, int wc, int fr, int fq) const {
        const int row0 = u.pm * BM + wr * 64 + fr, col0 = u.pn * BM + wc * 32 + 8 * fq;
#pragma unroll
        for (int ai = 0; ai < 2; ++ai)
#pragma unroll
            for (int m = 0; m < 4; ++m)
#pragma unroll
                for (int bj = 0; bj < 2; ++bj) { const size_t o = (size_t)(row0 + ai * HALF + m * 16) * DM + col0 + bj * HALF; const u32x4 g = *(const u32x4*)(GA + o);
                    const f32x4 g0 = {bflo(g.x), bfhi(g.x), bflo(g.y), bfhi(g.y)}, g1 = {bflo(g.z), bfhi(g.z), bflo(g.w), bfhi(g.w)};
                    *(f32x4*)(T1 + o) = g0 * acc[ai][bj][m][0]; *(f32x4*)(T1 + o + 4) = g1 * acc[ai][bj][m][1]; }
    }
};
struct EpiMergeB {
    static constexpr bool PERM = true;
    const float* T1; const bf16_t* GB; bf16_t* MM;
    __device__ __forceinline__ void operator()(const f32x4 (&acc)[2][2][4][2], const Unit& u, int wr, int wc, int fr, int fq) const {
        const int row0 = u.pm * BM + wr * 64 + fr, col0 = u.pn * BM + wc * 32 + 8 * fq;
#pragma unroll
        for (int ai = 0; ai < 2; ++ai)
#pragma unroll
            for (int m = 0; m < 4; ++m)
#pragma unroll
                for (int bj = 0; bj < 2; ++bj) { const size_t o = (size_t)(row0 + ai * HALF + m * 16) * DM + col0 + bj * HALF; const u32x4 g = *(const u32x4*)(GB + o);
                    const f32x4 g0 = {bflo(g.x), bfhi(g.x), bflo(g.y), bfhi(g.y)}, g1 = {bflo(g.z), bfhi(g.z), bflo(g.w), bfhi(g.w)};
                    const f32x4 t0 = *(const f32x4*)(T1 + o), t1 = *(const f32x4*)(T1 + o + 4);
                    *(u32x4*)(MM + o) = pack8(t0 + g0 * acc[ai][bj][m][0], t1 + g1 * acc[ai][bj][m][1]); }
    }
};
struct EpiPool {
    static constexpr bool PERM = true;
    bf16_t* PM; const float* pscale; int g;
    __device__ __forceinline__ void operator()(const f32x4 (&acc)[2][2][4][2], const Unit& u, int wr, int wc, int fr, int fq) const {
        const int row0 = u.pm * BM + wr * 64 + fr, col0 = g * BM + wc * 32 + 8 * fq;
#pragma unroll
        for (int bj = 0; bj < 2; ++bj) { const f32x4 s0 = *(const f32x4*)(pscale + col0 + bj * HALF), s1 = *(const f32x4*)(pscale + col0 + bj * HALF + 4);
#pragma unroll
            for (int ai = 0; ai < 2; ++ai)
#pragma unroll
                for (int m = 0; m < 4; ++m) *(u32x4*)(PM + (size_t)(row0 + ai * HALF + m * 16) * 1024 + col0 + bj * HALF) = pack8(acc[ai][bj][m][0] * s0, acc[ai][bj][m][1] * s1); }
    }
};

template <class Epi, class Sched, bool ALIGN_EPI>
__device__ __forceinline__ void gemm_phase(LAS unsigned char* lds, const Gemm g, const Sched& S, const Epi& E) {
    int tid = threadIdx.x; asm volatile("" : "+v"(tid));
    const int wid = __builtin_amdgcn_readfirstlane(tid >> 6), lane = tid & 63, wr = wid >> 2, wc = wid & 3, fr = lane & 15, fq = lane >> 4;
    const int K = g.K, nt = K / BK;
    unsigned voffA[2], voffB[2];
#pragma unroll
    for (int i = 0; i < 2; ++i) { int R, C; stage_rc(tid * 16 + i * 8192, R, C); const int Rb = Epi::PERM ? ((R & ~31) + perm32(R & 31)) : R;
        voffA[i] = (unsigned)(R * g.lda + C) * 2u; voffB[i] = (unsigned)(Rb * g.ldb + C) * 2u; }
    const size_t kstep = (size_t)(BK * 2);
    const size_t hstepA = (size_t)HALF * g.lda * 2, hstepB = (size_t)HALF * g.ldb * 2;
    const size_t tstepA = 2 * hstepA, tstepB = 2 * hstepB;
    const unsigned ldsw = (unsigned)wid * 1024u;
    const int aoff = lds_byte(wr * 64 + fr, fq * 8), boff = lds_byte(wc * 32 + fr, fq * 8);
#define PG8_SA(b, h) (((b) * 2 + (h)) * HTB)
#define PG8_SB(b, h) ((4 + (b) * 2 + (h)) * HTB)
#define PG8_STAGE(bufoff, gbase, voff) do { _Pragma("unroll") for (int _i = 0; _i < 2; ++_i) \
        __builtin_amdgcn_global_load_lds((const unsigned*)((const char*)(gbase) + (voff)[_i]), (LAS unsigned*)(lds + (bufoff) + ldsw + _i * 8192), 16, 0, 0); } while (0)
#define PG8_LDA(dst, b, h) do { _Pragma("unroll") for (int m = 0; m < 4; ++m) _Pragma("unroll") for (int k = 0; k < 2; ++k) dst[m][k] = *(const LAS bf16x8*)(lds + PG8_SA(b, h) + aoff + m * 2048 + k * 1024); } while (0)
#define PG8_LDB(dst, b, h) do { _Pragma("unroll") for (int n = 0; n < 2; ++n) _Pragma("unroll") for (int k = 0; k < 2; ++k) dst[n][k] = *(const LAS bf16x8*)(lds + PG8_SB(b, h) + boff + n * 2048 + k * 1024); } while (0)
#define PG8_MMA(ai, bj, At, Bt) do { __builtin_amdgcn_s_setprio(1); _Pragma("unroll") for (int m = 0; m < 4; ++m) _Pragma("unroll") for (int n = 0; n < 2; ++n) _Pragma("unroll") for (int k = 0; k < 2; ++k) \
        acc[ai][bj][m][n] = __builtin_amdgcn_mfma_f32_16x16x32_bf16(Bt[n][k], At[m][k], acc[ai][bj][m][n], 0, 0, 0); __builtin_amdgcn_s_setprio(0); } while (0)
#define PG8_WAIT_V(n) asm volatile("s_waitcnt vmcnt(" #n ")" ::: "memory")
#define PG8_WAIT_L(n) asm volatile("s_waitcnt lgkmcnt(" #n ")" ::: "memory")
#define PG8_BAR __builtin_amdgcn_s_barrier()
#define PG8_SCHED __builtin_amdgcn_sched_barrier(0)
    Unit cur, nxt; int ui = 0;
    if (!S.next(0, cur)) return;
    f32x4 acc[2][2][4][2];
#pragma unroll
    for (int a = 0; a < 2; ++a)
#pragma unroll
        for (int b = 0; b < 2; ++b)
#pragma unroll
            for (int m = 0; m < 4; ++m)
#pragma unroll
                for (int n = 0; n < 2; ++n) acc[a][b][m][n] = (f32x4){0.f, 0.f, 0.f, 0.f};
    bf16x8 At[4][2], B0[2][2], B1[2][2];
    const char* cA = (const char*)g.A + (size_t)cur.pm * tstepA; const char* cB = (const char*)g.Bt + (size_t)cur.pn * tstepB;
    PG8_STAGE(PG8_SB(0, 0), cB, voffB); PG8_STAGE(PG8_SB(0, 1), cB + hstepB, voffB); PG8_STAGE(PG8_SA(0, 0), cA, voffA); PG8_STAGE(PG8_SA(0, 1), cA + hstepA, voffA);
    if (wr == 1) PG8_BAR;
    PG8_WAIT_V(2); PG8_BAR;
    PG8_STAGE(PG8_SB(1, 0), cB + kstep, voffB); PG8_STAGE(PG8_SA(1, 0), cA + kstep, voffA); PG8_STAGE(PG8_SB(1, 1), cB + hstepB + kstep, voffB);
    PG8_WAIT_V(6); PG8_BAR;
    for (;;) {
        const bool has_next = S.next(ui + 1, nxt);
        const char* nA = has_next ? (const char*)g.A + (size_t)nxt.pm * tstepA : cA; const char* nB = has_next ? (const char*)g.Bt + (size_t)nxt.pn * tstepB : cB;
#pragma unroll 1
        for (int t = 0; t < nt; t += 2) {
            const bool last = (t == nt - 2);
            const char* a1 = cA + (size_t)(t + 1) * kstep;
            const char* a2 = last ? nA : cA + (size_t)(t + 2) * kstep; const char* b2 = last ? nB : cB + (size_t)(t + 2) * kstep;
            const char* a3 = a2 + kstep; const char* b3 = b2 + kstep;
            PG8_LDB(B0, 0, 0); PG8_LDB(B1, 0, 1); PG8_SCHED; PG8_LDA(At, 0, 0); PG8_STAGE(PG8_SA(1, 1), a1 + hstepA, voffA);
            PG8_WAIT_V(8); PG8_WAIT_L(0); PG8_BAR; PG8_MMA(0, 0, At, B0); PG8_MMA(0, 1, At, B1); PG8_BAR; PG8_SCHED;
            PG8_LDA(At, 0, 1); PG8_STAGE(PG8_SB(0, 0), b2, voffB); PG8_STAGE(PG8_SB(0, 1), b2 + hstepB, voffB); PG8_STAGE(PG8_SA(0, 0), a2, voffA);
            PG8_WAIT_V(8); PG8_WAIT_L(0); PG8_BAR; PG8_MMA(1, 0, At, B0); PG8_MMA(1, 1, At, B1); PG8_BAR; PG8_SCHED;
            PG8_LDB(B0, 1, 0); PG8_LDB(B1, 1, 1); PG8_SCHED; PG8_LDA(At, 1, 0); PG8_STAGE(PG8_SA(0, 1), a2 + hstepA, voffA);
            PG8_WAIT_V(8); PG8_WAIT_L(0); PG8_BAR; PG8_MMA(0, 0, At, B0); PG8_MMA(0, 1, At, B1); PG8_BAR; PG8_SCHED;
            PG8_LDA(At, 1, 1); PG8_STAGE(PG8_SB(1, 0), b3, voffB); PG8_STAGE(PG8_SB(1, 1), b3 + hstepB, voffB); PG8_STAGE(PG8_SA(1, 0), a3, voffA);
            PG8_WAIT_V(8); PG8_WAIT_L(0); PG8_BAR; PG8_MMA(1, 0, At, B0); PG8_MMA(1, 1, At, B1); PG8_BAR; PG8_SCHED;
        }
        if constexpr (ALIGN_EPI) { if (wr == 0) PG8_BAR; }
        E(acc, cur, wr, wc, fr, fq);
        if (!has_next) break;
#pragma unroll
        for (int a = 0; a < 2; ++a)
#pragma unroll
            for (int b = 0; b < 2; ++b)
#pragma unroll
                for (int m = 0; m < 4; ++m)
#pragma unroll
                    for (int n = 0; n < 2; ++n) acc[a][b][m][n] = (f32x4){0.f, 0.f, 0.f, 0.f};
        cur = nxt; cA = nA; cB = nB; ++ui;
        if constexpr (ALIGN_EPI) { if (wr == 1) PG8_BAR; }
    }
    PG8_WAIT_V(0);
    if constexpr (!ALIGN_EPI) { if (wr == 0) PG8_BAR; }
    PG8_BAR;
#undef PG8_SA
#undef PG8_SB
#undef PG8_STAGE
#undef PG8_LDA
#undef PG8_LDB
#undef PG8_MMA
#undef PG8_WAIT_V
#undef PG8_WAIT_L
#undef PG8_BAR
#undef PG8_SCHED
}
}

struct Args { const float* in[21]; float* out; unsigned char* ws; int pad0, pad1; };
#define LDS_WAIT() asm volatile("s_waitcnt lgkmcnt(0)" ::: "memory")
#define GRID_SYNC() do { asm volatile("s_waitcnt vmcnt(0)" ::: "memory"); grid.sync(); __builtin_amdgcn_fence(__ATOMIC_ACQUIRE, "agent"); asm volatile("s_waitcnt vmcnt(0)" ::: "memory"); __syncthreads(); } while (0)

__device__ __forceinline__ int dest_row(int mode, int n) {
    if (mode == 1) { const int half = n >= DFF ? 1 : 0; const int j = n - half * DFF; return ((j >> 7) << 8) + (half << 7) + (j & 127); }
    if (mode == 2) { if (n < 1024 || (n >= 3072 && n < 4096)) { const int d = n & 127, half = d >> 6, dd = d & 63, i = dd & 31, nb = dd >> 5, rho = 32 * half + i;
            return (n & ~127) + 32 * (rho >> 4) + 8 * ((rho >> 2) & 3) + 4 * nb + (rho & 3); } return n; }
    return n;
}
__device__ __forceinline__ void tr_item(const float* W, int K, int N, bf16_t* WT, int row_off, int mode, LAS float* scr, int item, int lane) {
    const int nblk = N >> 6, kb = item / nblk, nb = item - kb * nblk, k0 = kb << 6, n0 = nb << 6;
    f32x4 v[16];
#pragma unroll
    for (int i = 0; i < 16; ++i) { const int idx = i * 64 + lane, kk = idx >> 4, c4 = idx & 15; v[i] = *(const f32x4*)(W + (size_t)(k0 + kk) * N + n0 + 4 * c4); }
#pragma unroll
    for (int i = 0; i < 16; ++i) { const int idx = i * 64 + lane, kk = idx >> 4, c4 = idx & 15; LAS float* s = scr + kk * 65 + 4 * c4; s[0] = v[i][0]; s[1] = v[i][1]; s[2] = v[i][2]; s[3] = v[i][3]; }
    LDS_WAIT(); asm volatile("" ::: "memory");
    const int c = lane & 7;
#pragma unroll
    for (int j = 0; j < 8; ++j) { const int n = (lane >> 3) + 8 * j; const LAS float* s = scr + (8 * c) * 65 + n;
        u32x4 o; o.x = pk2(s[0], s[65]); o.y = pk2(s[2 * 65], s[3 * 65]); o.z = pk2(s[4 * 65], s[5 * 65]); o.w = pk2(s[6 * 65], s[7 * 65]);
        *(u32x4*)(WT + (size_t)(row_off + dest_row(mode, n0 + n)) * K + k0 + 8 * c) = o; }
    LDS_WAIT(); asm volatile("" ::: "memory");
}

__device__ __forceinline__ void norm_rows(const float* src_lat, const float* src_ctx, int nrows, const float* gvec, const float* mod, int shidx, int scidx, bf16_t* dst, int gw, int NGW, int lane) {
    for (int r = gw; r < nrows; r += NGW) {
        const float* src = r < NLAT ? src_lat + (size_t)r * DM : src_ctx + (size_t)(r - NLAT) * DM;
        const int bsel = r < SEQ ? 0 : (r < NLAT ? 1 : 2);
        const f32x4* s4 = (const f32x4*)src + lane;
        f32x4 v[8]; float ss = 0.f;
#pragma unroll
        for (int j = 0; j < 8; ++j) { v[j] = s4[64 * j]; ss += (v[j][0] * v[j][0] + v[j][1] * v[j][1]) + (v[j][2] * v[j][2] + v[j][3] * v[j][3]); }
        const float rstd = 1.0f / sqrtf(wave_sum(ss) * (1.0f / DM) + 1e-6f);
        const f32x4* g4 = (const f32x4*)gvec + lane; const f32x4* sc4 = (const f32x4*)(mod + bsel * NMOD + scidx * DM) + lane; const f32x4* sh4 = (const f32x4*)(mod + bsel * NMOD + shidx * DM) + lane;
        u32x2* o8 = (u32x2*)(dst + (size_t)r * DM) + lane;
#pragma unroll
        for (int j = 0; j < 8; ++j) { const f32x4 y = v[j] * rstd * g4[64 * j]; const f32x4 o = y * (sc4[64 * j] + 1.0f) + sh4[64 * j]; u32x2 w; w.x = pk2(o[0], o[1]); w.y = pk2(o[2], o[3]); o8[64 * j] = w; }
    }
}

__device__ __forceinline__ s16x4 lds_tr(const LAS unsigned char* p) { return __builtin_amdgcn_ds_read_tr16_b64_v4i16((LAS s16x4*)p); }
__device__ __forceinline__ bf16x8 lds_tr8(const LAS unsigned char* base, int pitch, int k0, int n0, int lane) {
    const int g = lane >> 4, q = (lane & 15) >> 2, p = lane & 3;
    const LAS unsigned char* a = base + (k0 + 8 * g + q) * pitch + (n0 + 4 * p) * 2;
    const s16x4 lo = lds_tr(a), hi = lds_tr(a + 4 * pitch);
    return (bf16x8){lo[0], lo[1], lo[2], lo[3], hi[0], hi[1], hi[2], hi[3]};
}
__device__ __forceinline__ float log2_gamma(const float* decay_logit, int dir, int h) { const float x = decay_logit[dir * 8 + h]; return -log1pf(expf(-x)) * LOG2E; }
__device__ __forceinline__ int slot_row0(int b, int slot) { return slot < 2 ? NLAT + b * CTXL + slot * 128 : b * SEQ + (slot - 2) * 128; }

__device__ __forceinline__ void r1_task(LAS unsigned char* lds, int task, const bf16_t* Kg, const bf16_t* Vg, bf16_t* KVS, const float* decay_logit) {
    int tid = threadIdx.x; asm volatile("" : "+v"(tid));
    const int lane = tid & 63, w = tid >> 6, g = lane >> 4, r16 = lane & 15;
    const int bh = task / NSLOT, slot = task - bh * NSLOT, b = bh >> 3, h = bh & 7, row0 = slot_row0(b, slot);
    const float l2f = log2_gamma(decay_logit, 0, h), l2b = log2_gamma(decay_logit, 1, h);
    LAS unsigned char* VS = lds; LAS unsigned char* KF = lds + 67584; LAS unsigned char* KB = lds + 67584 + 34816;
#pragma unroll
    for (int it = 0; it < 8; ++it) { const int p = tid + it * 512, r = p >> 5, cc = p & 31; *(LAS u32x4*)(VS + r * 528 + cc * 16) = *(const u32x4*)(Vg + (size_t)(row0 + r) * DM + h * 256 + cc * 8); }
#pragma unroll
    for (int it = 0; it < 4; ++it) { const int p = tid + it * 512, r = p >> 4, cc = p & 15; const u32x4 kv = *(const u32x4*)(Kg + (size_t)(row0 + r) * 1024 + h * 128 + cc * 8);
        const float wf = __builtin_amdgcn_exp2f(l2f * (float)(127 - r)), wb = __builtin_amdgcn_exp2f(l2b * (float)r);
        u32x4 of, ob;
        of.x = pk2(bflo(kv.x) * wf, bfhi(kv.x) * wf); of.y = pk2(bflo(kv.y) * wf, bfhi(kv.y) * wf); of.z = pk2(bflo(kv.z) * wf, bfhi(kv.z) * wf); of.w = pk2(bflo(kv.w) * wf, bfhi(kv.w) * wf);
        ob.x = pk2(bflo(kv.x) * wb, bfhi(kv.x) * wb); ob.y = pk2(bflo(kv.y) * wb, bfhi(kv.y) * wb); ob.z = pk2(bflo(kv.z) * wb, bfhi(kv.z) * wb); ob.w = pk2(bflo(kv.w) * wb, bfhi(kv.w) * wb);
        *(LAS u32x4*)(KF + r * 272 + cc * 16) = of; *(LAS u32x4*)(KB + r * 272 + cc * 16) = ob; }
    __syncthreads();
#pragma unroll 1
    for (int dir = 0; dir < 2; ++dir) {
        const LAS unsigned char* KW = dir == 0 ? KF : KB;
        f32x4 af[8][2];
#pragma unroll
        for (int mb = 0; mb < 8; ++mb)
#pragma unroll
            for (int nb = 0; nb < 2; ++nb) af[mb][nb] = (f32x4){0.f, 0.f, 0.f, 0.f};
#pragma unroll
        for (int ks = 0; ks < 4; ++ks) {
            bf16x8 bv[2];
#pragma unroll
            for (int nb = 0; nb < 2; ++nb) bv[nb] = lds_tr8(VS, 528, 32 * ks, 32 * w + 16 * nb, lane);
#pragma unroll
            for (int mb = 0; mb < 8; ++mb) { const bf16x8 kf = lds_tr8(KW, 272, 32 * ks, 16 * mb, lane);
#pragma unroll
                for (int nb = 0; nb < 2; ++nb) af[mb][nb] = __builtin_amdgcn_mfma_f32_16x16x32_bf16(kf, bv[nb], af[mb][nb], 0, 0, 0); }
            __builtin_amdgcn_sched_barrier(0);
        }
        bf16_t* of_ = KVS + ((size_t)(bh * NSLOT + slot) * 2 + dir) * 32768;
#pragma unroll
        for (int mb = 0; mb < 8; ++mb)
#pragma unroll
            for (int nb = 0; nb < 2; ++nb) { const int e = 32 * w + 16 * nb + r16, d = 16 * mb + 4 * g; u32x2 o;
                o.x = pk2(af[mb][nb][0], af[mb][nb][1]); o.y = pk2(af[mb][nb][2], af[mb][nb][3]); *(u32x2*)(of_ + e * 128 + d) = o; }
    }
    __syncthreads();
}

__device__ __forceinline__ void r3_task(LAS unsigned char* lds, int task, const bf16_t* Qg, const bf16_t* Kg, const bf16_t* Vg, const bf16_t* KVS, const bf16_t* Gs, bf16_t* ZA, const float* decay_logit) {
    int tid = threadIdx.x; asm volatile("" : "+v"(tid));
    const int lane = tid & 63, w = tid >> 6, g = lane >> 4, r16 = lane & 15;
    const int bh = task >> 5, c = task & 31, b = bh >> 3, h = bh & 7, row0 = b * SEQ + c * 128;
    const float l2f = log2_gamma(decay_logit, 0, h), l2b = log2_gamma(decay_logit, 1, h);
    LAS unsigned char* QS = lds; LAS unsigned char* KS = lds + 34816; LAS unsigned char* CS = lds + 69632;
#pragma unroll
    for (int it = 0; it < 4; ++it) { const int p = tid + it * 512, r = p >> 4, cc = p & 15;
        *(LAS u32x4*)(QS + r * 272 + cc * 16) = *(const u32x4*)(Qg + (size_t)(row0 + r) * 1024 + h * 128 + cc * 8);
        *(LAS u32x4*)(KS + r * 272 + cc * 16) = *(const u32x4*)(Kg + (size_t)(row0 + r) * 1024 + h * 128 + cc * 8); }
#pragma unroll
    for (int it = 0; it < 8; ++it) { const int p = tid + it * 512, r = p >> 5, cc = p & 31; *(LAS u32x4*)(CS + r * 528 + cc * 16) = *(const u32x4*)(Vg + (size_t)(row0 + r) * DM + h * 256 + cc * 8); }
    __syncthreads();
    f32x4 pa[8];
#pragma unroll
    for (int mb = 0; mb < 8; ++mb) pa[mb] = (f32x4){0.f, 0.f, 0.f, 0.f};
    bf16x8 qf[4];
#pragma unroll
    for (int ks = 0; ks < 4; ++ks) qf[ks] = *(const LAS bf16x8*)(QS + (16 * w + r16) * 272 + (32 * ks + 8 * g) * 2);
#pragma unroll
    for (int ks = 0; ks < 4; ++ks)
#pragma unroll
        for (int mb = 0; mb < 8; ++mb) { const bf16x8 kf = *(const LAS bf16x8*)(KS + (16 * mb + r16) * 272 + (32 * ks + 8 * g) * 2); pa[mb] = __builtin_amdgcn_mfma_f32_16x16x32_bf16(kf, qf[ks], pa[mb], 0, 0, 0); }
    {   const int i = 16 * w + r16;
#pragma unroll
        for (int mb = 0; mb < 8; ++mb)
#pragma unroll
            for (int jj = 0; jj < 4; ++jj) { const int j = 16 * mb + 4 * g + jj; const int dd = i - j;
                const float f = dd > 0 ? __builtin_amdgcn_exp2f(l2f * (float)dd) : (dd < 0 ? __builtin_amdgcn_exp2f(l2b * (float)(-dd)) : 2.0f); pa[mb][jj] *= f; }
    }
    __syncthreads();
#pragma unroll
    for (int mb = 0; mb < 8; ++mb) { u32x2 o; o.x = pk2(pa[mb][0], pa[mb][1]); o.y = pk2(pa[mb][2], pa[mb][3]); *(LAS u32x2*)(KS + (16 * w + r16) * 272 + (16 * mb + 4 * g) * 2) = o; }
    LDS_WAIT(); asm volatile("" ::: "memory");
    f32x4 acc[16];
#pragma unroll
    for (int nb = 0; nb < 16; ++nb) acc[nb] = (f32x4){0.f, 0.f, 0.f, 0.f};
#pragma unroll
    for (int ks = 0; ks < 4; ++ks) { const bf16x8 pf = *(const LAS bf16x8*)(KS + (16 * w + r16) * 272 + (32 * ks + 8 * g) * 2);
#pragma unroll
        for (int nb = 0; nb < 16; ++nb) { const bf16x8 vf = lds_tr8(CS, 528, 32 * ks, 16 * nb, lane); acc[nb] = __builtin_amdgcn_mfma_f32_16x16x32_bf16(pf, vf, acc[nb], 0, 0, 0); if ((nb & 3) == 3) __builtin_amdgcn_sched_barrier(0); } }
#pragma unroll 1
    for (int dir = 0; dir < 2; ++dir) {
        __syncthreads();
        const bf16_t* Sg = KVS + ((size_t)(bh * NSLOT + c + 2) * 2 + dir) * 32768;
#pragma unroll
        for (int it = 0; it < 8; ++it) { const int p = tid + it * 512, r = p >> 4, cc = p & 15; *(LAS u32x4*)(CS + r * 272 + cc * 16) = *(const u32x4*)(Sg + (size_t)r * 128 + cc * 8); }
        __syncthreads();
        const int ia = 16 * w + r16; const float sf = dir == 0 ? __builtin_amdgcn_exp2f(l2f * (float)(ia + 1)) : __builtin_amdgcn_exp2f(l2b * (float)(128 - ia));
#pragma unroll
        for (int ks = 0; ks < 4; ++ks) { bf16x8 qs; const bf16x8 q0 = *(const LAS bf16x8*)(QS + (16 * w + r16) * 272 + (32 * ks + 8 * g) * 2);
#pragma unroll
            for (int e = 0; e < 8; e += 2) { const unsigned pk = pk2(bf1(q0[e]) * sf, bf1(q0[e + 1]) * sf); qs[e] = (short)(pk & 0xffffu); qs[e + 1] = (short)(pk >> 16); }
#pragma unroll
            for (int nb = 0; nb < 16; ++nb) { const bf16x8 sfr = *(const LAS bf16x8*)(CS + (16 * nb + r16) * 272 + (32 * ks + 8 * g) * 2); acc[nb] = __builtin_amdgcn_mfma_f32_16x16x32_bf16(qs, sfr, acc[nb], 0, 0, 0); if ((nb & 3) == 3) __builtin_amdgcn_sched_barrier(0); } }
    }
#pragma unroll
    for (int jj = 0; jj < 4; ++jj) {
        float s = 0.f;
#pragma unroll
        for (int nb = 0; nb < 16; ++nb) s += acc[nb][jj];
        s += __shfl_xor(s, 1); s += __shfl_xor(s, 2); s += __shfl_xor(s, 4); s += __shfl_xor(s, 8);
        const float mu = s * (1.0f / 256.0f); float q = 0.f;
#pragma unroll
        for (int nb = 0; nb < 16; ++nb) { const float d = acc[nb][jj] - mu; q += d * d; }
        q += __shfl_xor(q, 1); q += __shfl_xor(q, 2); q += __shfl_xor(q, 4); q += __shfl_xor(q, 8);
        const float rstd = 1.0f / sqrtf(q * (1.0f / 256.0f) + 1e-5f);
        const size_t ro = (size_t)(row0 + 16 * w + 4 * g + jj) * DM + h * 256 + r16;
#pragma unroll
        for (int nb = 0; nb < 16; ++nb) { const float gs = __builtin_bit_cast(float, ((unsigned)Gs[ro + 16 * nb]) << 16); ZA[ro + 16 * nb] = (bf16_t)f2bf(gs * (acc[nb][jj] - mu) * rstd); }
    }
    __syncthreads();
}

__global__ void __launch_bounds__(512, 2) fwd_megakernel(Args args) {
    extern __shared__ __attribute__((aligned(16))) unsigned char lds_raw[];
    LAS unsigned char* lds = (LAS unsigned char*)lds_raw;
    cg::grid_group grid = cg::this_grid();
    const int tid = threadIdx.x, lane = tid & 63, wave = __builtin_amdgcn_readfirstlane(tid >> 6);
    const int G = gridDim.x, bx = blockIdx.x;
    const int gw = bx * 8 + wave, NGW = G * 8;
    unsigned char* ws = args.ws;
    const float* x = args.in[0]; const float* cvec = args.in[1]; const float* ctx = args.in[2]; const float* cctx = args.in[3];
    const float* w_ada = args.in[4]; const float* b_ada = args.in[5]; const float* norm_g = args.in[6];
    const float* decay_logit = args.in[12]; const float* pool_scale = args.in[14]; const float* b_gate = args.in[18]; const float* final_g = args.in[20];
    float* out = args.out;
    float* MOD = (float*)(ws + WS_MOD); float* ROPE = (float*)(ws + WS_ROPE);
    bf16_t* W13A = (bf16_t*)(ws + WS_W13A); bf16_t* W2A = (bf16_t*)(ws + WS_W2A); bf16_t* W13B = (bf16_t*)(ws + WS_W13B); bf16_t* W2B = (bf16_t*)(ws + WS_W2B);
    bf16_t* WIN = (bf16_t*)(ws + WS_WIN); bf16_t* WOA = (bf16_t*)(ws + WS_WOA); bf16_t* WOB = (bf16_t*)(ws + WS_WOB); bf16_t* WOUT = (bf16_t*)(ws + WS_WOUT); bf16_t* POOLW = (bf16_t*)(ws + WS_POOLW);
    bf16_t* AN = (bf16_t*)(ws + WS_AN); bf16_t* H = (bf16_t*)(ws + WS_H); float* HC1 = (float*)(ws + WS_HC1);
    bf16_t* Kb = (bf16_t*)(ws + WS_K); bf16_t* Qb = (bf16_t*)(ws + WS_Q); bf16_t* Vb = (bf16_t*)(ws + WS_V); bf16_t* Gb = (bf16_t*)(ws + WS_G); bf16_t* PIN = (bf16_t*)(ws + WS_PIN);
    bf16_t* GA = (bf16_t*)(ws + WS_GA); bf16_t* GB = (bf16_t*)(ws + WS_GB); bf16_t* POOLED = (bf16_t*)(ws + WS_POOLED); bf16_t* PM = (bf16_t*)(ws + WS_PM);
    bf16_t* KVS = H; float* T1 = (float*)H; bf16_t* ZA = AN; bf16_t* MMb = Gb;

    for (int i = bx * 512 + tid; i < 3 * NMOD; i += G * 512) MOD[i] = 0.f;
    GRID_SYNC();
    {
        LAS float* scr = (LAS float*)(lds + wave * 16640);
        constexpr int I_13 = 32 * 176, I_2 = 88 * 32, I_IN = 32 * 112, I_GT = 32 * 64, I_OA = 32 * 32, I_OB = 16 * 32, I_OUT = 32 * 32, I_PW = 16;
        constexpr int NIT = 2 * I_13 + 2 * I_2 + I_IN + I_GT + I_OA + I_OB + I_OUT + 4 * I_PW;
        for (int it = gw; it < NIT; it += NGW) {
            int r = it;
            if (r < I_13) { tr_item(args.in[7], DM, 2 * DFF, W13A, 0, 1, scr, r, lane); continue; } r -= I_13;
            if (r < I_13) { tr_item(args.in[9], DM, 2 * DFF, W13B, 0, 1, scr, r, lane); continue; } r -= I_13;
            if (r < I_2) { tr_item(args.in[8], DFF, DM, W2A, 0, 0, scr, r, lane); continue; } r -= I_2;
            if (r < I_2) { tr_item(args.in[10], DFF, DM, W2B, 0, 0, scr, r, lane); continue; } r -= I_2;
            if (r < I_IN) { tr_item(args.in[11], DM, 7168, WIN, 0, 2, scr, r, lane); continue; } r -= I_IN;
            if (r < I_GT) { tr_item(args.in[17], DM, 4096, WIN, 7168, 0, scr, r, lane); continue; } r -= I_GT;
            if (r < I_OA) { tr_item(args.in[15], DM, DM, WOA, 0, 0, scr, r, lane); continue; } r -= I_OA;
            if (r < I_OB) { tr_item(args.in[16], 1024, DM, WOB, 0, 0, scr, r, lane); continue; } r -= I_OB;
            if (r < I_OUT) { tr_item(args.in[19], DM, DM, WOUT, 0, 0, scr, r, lane); continue; } r -= I_OUT;
            { const int gp = r >> 4; tr_item(args.in[13] + (size_t)gp * 65536, 256, 256, POOLW + (size_t)gp * 65536, 0, 0, scr, r & 15, lane); }
        }
        for (int it = gw; it < 72 * 32; it += NGW) {
            const int cgp = it % 72, kc = it / 72, col = cgp * 256 + lane * 4, k = kc * 64 + lane;
            const float s0 = fsilu(cvec[k]), s1 = fsilu(cvec[DM + k]), s2 = fsilu(cctx[k]);
            f32x4 a0 = {0.f, 0.f, 0.f, 0.f}, a1 = a0, a2 = a0;
#pragma unroll 16
            for (int kk = 0; kk < 64; ++kk) { const f32x4 wv = *(const f32x4*)(w_ada + (size_t)(kc * 64 + kk) * NMOD + col);
                a0 += wv * __shfl(s0, kk); a1 += wv * __shfl(s1, kk); a2 += wv * __shfl(s2, kk); }
            if (kc == 0) { const f32x4 bv = *(const f32x4*)(b_ada + col); a0 += bv; a1 += bv; a2 += bv; }
#pragma unroll
            for (int e = 0; e < 4; ++e) { __hip_atomic_fetch_add(MOD + col + e, a0[e], __ATOMIC_RELAXED, __HIP_MEMORY_SCOPE_AGENT); __hip_atomic_fetch_add(MOD + NMOD + col + e, a1[e], __ATOMIC_RELAXED, __HIP_MEMORY_SCOPE_AGENT);
                __hip_atomic_fetch_add(MOD + 2 * NMOD + col + e, a2[e], __ATOMIC_RELAXED, __HIP_MEMORY_SCOPE_AGENT); }
        }
        { const int id = bx * 512 + tid; if (id < 2048) { const int pos = id >> 5, i = id & 31; const float inv = powf(10000.0f, -(float)i * (1.0f / 32.0f)); const float ang = (float)pos * inv; ROPE[2 * id] = cosf(ang); ROPE[2 * id + 1] = sinf(ang); } }
    }
    GRID_SYNC();
#if defined(STOP) && STOP == 100
    for (size_t i = (size_t)bx * 512 + tid; i < (size_t)NLAT * DM; i += (size_t)G * 512) out[i] = bf1((short)WIN[i]) + (i + (size_t)NLAT * DM < (size_t)11264 * 2048 ? bf1((short)WIN[i + (size_t)NLAT * DM]) : 0.f);
    return;
#endif
    norm_rows(x, ctx, MT, norm_g, MOD, 0, 1, AN, gw, NGW, lane);
    GRID_SYNC();
    { pg8::Gemm g{AN, W13A, DM, DM, DM}; pg8::MixOrder S; S.init(32, 44, 2, 44, G, bx); pg8::EpiSwiglu E{H, DFF}; pg8::gemm_phase<pg8::EpiSwiglu, pg8::MixOrder, true>(lds, g, S, E); }
    GRID_SYNC();
    { pg8::Gemm g{H, W2A, DFF, DFF, DFF}; pg8::MixOrder S; S.init(32, 8, 2, 8, G, bx); pg8::EpiResid E{x, ctx, out, HC1, MOD, 2, 0.5f}; pg8::gemm_phase<pg8::EpiResid, pg8::MixOrder, true>(lds, g, S, E); }
    GRID_SYNC();
#if defined(STOP) && STOP == 3
    return;
#endif
    norm_rows(out, HC1, MT, norm_g + DM, MOD, 3, 4, AN, gw, NGW, lane);
    GRID_SYNC();
#if defined(STOP) && STOP == 4
    for (size_t i = (size_t)bx * 512 + tid; i < (size_t)NLAT * DM; i += (size_t)G * 512) out[i] = bf1((short)AN[i]) + ((i >> 11) < 512 ? bf1((short)AN[i + (size_t)NLAT * DM]) : 0.f);
    return;
#endif
    { pg8::Gemm g{AN, WIN, DM, DM, DM}; pg8::MixOrder S; S.init(32, 44, 2, 12, G, bx); pg8::EpiIn E{Kb, Qb, Vb, Gb, PIN, GA, GB, b_gate, ROPE}; pg8::gemm_phase<pg8::EpiIn, pg8::MixOrder, true>(lds, g, S, E); }
    GRID_SYNC();
#if defined(STOP) && STOP == 5
    for (size_t i = (size_t)bx * 512 + tid; i < (size_t)NLAT * DM; i += (size_t)G * 512) { const size_t r = i >> 11, c = i & 2047; out[i] = bf1((short)Kb[r * 1024 + (c & 1023)]) + bf1((short)Qb[r * 1024 + (c & 1023)]) + bf1((short)Vb[i]) + bf1((short)Gb[i]) + bf1((short)PIN[r * 1024 + (c & 1023)]) + bf1((short)GA[i]) + bf1((short)GB[i]); }
    return;
#endif
    for (int t = bx; t < 16 * NSLOT; t += G) r1_task(lds, t, Kb, Vb, KVS, decay_logit);
    for (int it = bx * 512 + tid; it < NLAT * 128; it += G * 512) {
        const int r = it >> 7, pc = it & 127, gp = pc >> 5, win = 2 << gp, lo = win >> 1, hi = win - 1 - lo, t = r & (SEQ - 1), rb = r - t;
        const int st = t - lo < 0 ? 0 : t - lo, en = t + hi + 1 > SEQ ? SEQ : t + hi + 1;
        float s[8] = {0.f, 0.f, 0.f, 0.f, 0.f, 0.f, 0.f, 0.f};
        for (int q = st; q < en; ++q) { const u32x4 v = *(const u32x4*)(PIN + (size_t)(rb + q) * 1024 + pc * 8);
            s[0] += bflo(v.x); s[1] += bfhi(v.x); s[2] += bflo(v.y); s[3] += bfhi(v.y); s[4] += bflo(v.z); s[5] += bfhi(v.z); s[6] += bflo(v.w); s[7] += bfhi(v.w); }
        const float ic = 1.0f / (float)(en - st); const u32x4 v = *(const u32x4*)(PIN + (size_t)r * 1024 + pc * 8);
        u32x4 o; o.x = pk2(s[0] * ic - bflo(v.x), s[1] * ic - bfhi(v.x)); o.y = pk2(s[2] * ic - bflo(v.y), s[3] * ic - bfhi(v.y)); o.z = pk2(s[4] * ic - bflo(v.z), s[5] * ic - bfhi(v.z)); o.w = pk2(s[6] * ic - bflo(v.w), s[7] * ic - bfhi(v.w));
        *(u32x4*)(POOLED + (size_t)r * 1024 + pc * 8) = o;
    }
    GRID_SYNC();
    for (int id = bx * 512 + tid; id < 16 * 2 * 4096; id += G * 512) {
        const int bh = id >> 13, dir = (id >> 12) & 1, off = (id & 4095) * 8, h = bh & 7;
        const float cd = __builtin_amdgcn_exp2f(log2_gamma(decay_logit, dir, h) * 128.0f);
        bf16_t* base = KVS + (size_t)bh * NSLOT * 65536 + dir * 32768 + off;
        float r[8] = {0.f, 0.f, 0.f, 0.f, 0.f, 0.f, 0.f, 0.f};
#pragma unroll 2
        for (int s = 0; s < NSLOT; ++s) {
            const int slot = dir == 0 ? s : (s == 0 ? 1 : (s == 1 ? 0 : NSLOT + 1 - s));
            u32x4* p = (u32x4*)(base + (size_t)slot * 65536); const u32x4 v = *p;
            u32x4 o; o.x = pk2(r[0], r[1]); o.y = pk2(r[2], r[3]); o.z = pk2(r[4], r[5]); o.w = pk2(r[6], r[7]); *p = o;
            r[0] = r[0] * cd + bflo(v.x); r[1] = r[1] * cd + bfhi(v.x); r[2] = r[2] * cd + bflo(v.y); r[3] = r[3] * cd + bfhi(v.y);
            r[4] = r[4] * cd + bflo(v.z); r[5] = r[5] * cd + bfhi(v.z); r[6] = r[6] * cd + bflo(v.w); r[7] = r[7] * cd + bfhi(v.w);
        }
    }
    { const int gp = (bx >> 5) & 3; pg8::Gemm g{POOLED + gp * 256, POOLW + (size_t)gp * 65536, 1024, 256, 256}; pg8::MixOrder S; S.init(32, 1, 0, 1, 1 << 20, bx < 128 ? (bx & 31) : 32);
        pg8::EpiPool E{PM, pool_scale, gp}; pg8::gemm_phase<pg8::EpiPool, pg8::MixOrder, true>(lds, g, S, E); }
    GRID_SYNC();
#if defined(STOP) && STOP == 7
    for (size_t i = (size_t)bx * 512 + tid; i < (size_t)NLAT * DM; i += (size_t)G * 512) { const size_t r = i >> 11, c = i & 2047; out[i] = bf1((short)POOLED[r * 1024 + (c & 1023)]) + bf1((short)PM[r * 1024 + (c & 1023)]) + bf1((short)KVS[i]) + bf1((short)KVS[i + (size_t)NLAT * DM]); }
    return;
#endif
    for (int t = bx; t < 512; t += G) r3_task(lds, t, Qb, Kb, Vb, KVS, Gb, ZA, decay_logit);
    GRID_SYNC();
#if defined(STOP) && STOP == 8
    for (size_t i = (size_t)bx * 512 + tid; i < (size_t)NLAT * DM; i += (size_t)G * 512) out[i] = bf1((short)ZA[i]);
    return;
#endif
    { pg8::Gemm g{ZA, WOA, DM, DM, DM}; pg8::MixOrder S; S.init(32, 8, 0, 1, G, bx); pg8::EpiMergeA E{T1, GA}; pg8::gemm_phase<pg8::EpiMergeA, pg8::MixOrder, true>(lds, g, S, E); }
    { pg8::Gemm g{PM, WOB, 1024, 1024, 1024}; pg8::MixOrder S; S.init(32, 8, 0, 1, G, bx); pg8::EpiMergeB E{T1, GB, MMb}; pg8::gemm_phase<pg8::EpiMergeB, pg8::MixOrder, true>(lds, g, S, E); }
    GRID_SYNC();
#if defined(STOP) && STOP == 9
    for (size_t i = (size_t)bx * 512 + tid; i < (size_t)NLAT * DM; i += (size_t)G * 512) out[i] = bf1((short)MMb[i]);
    return;
#endif
    { pg8::Gemm g{MMb, WOUT, DM, DM, DM}; pg8::MixOrder S; S.init(32, 8, 0, 1, G, bx); pg8::EpiResid E{out, out, out, out, MOD, 5, 1.0f}; pg8::gemm_phase<pg8::EpiResid, pg8::MixOrder, true>(lds, g, S, E); }
    GRID_SYNC();
    norm_rows(out, out, NLAT, norm_g + 2 * DM, MOD, 6, 7, AN, gw, NGW, lane);
    GRID_SYNC();
    { pg8::Gemm g{AN, W13B, DM, DM, DM}; pg8::MixOrder S; S.init(32, 44, 0, 1, G, bx); pg8::EpiSwiglu E{H, DFF}; pg8::gemm_phase<pg8::EpiSwiglu, pg8::MixOrder, true>(lds, g, S, E); }
    GRID_SYNC();
    { pg8::Gemm g{H, W2B, DFF, DFF, DFF}; pg8::MixOrder S; S.init(32, 8, 0, 1, G, bx); pg8::EpiResid E{out, out, out, out, MOD, 8, 0.5f}; pg8::gemm_phase<pg8::EpiResid, pg8::MixOrder, true>(lds, g, S, E); }
    GRID_SYNC();
    for (int r = gw; r < NLAT; r += NGW) {
        f32x4* s4 = (f32x4*)(out + (size_t)r * DM) + lane;
        f32x4 v[8]; float ss = 0.f;
#pragma unroll
        for (int j = 0; j < 8; ++j) { v[j] = s4[64 * j]; ss += (v[j][0] * v[j][0] + v[j][1] * v[j][1]) + (v[j][2] * v[j][2] + v[j][3] * v[j][3]); }
        const float rstd = 1.0f / sqrtf(wave_sum(ss) * (1.0f / DM) + 1e-6f);
        const f32x4* g4 = (const f32x4*)final_g + lane;
#pragma unroll
        for (int j = 0; j < 8; ++j) s4[64 * j] = v[j] * rstd * g4[64 * j];
    }
}

extern "C" void kernel_launch(void* const* d_in, const int* in_sizes, int n_in, void* d_out, int out_size, void* d_ws, size_t ws_size, hipStream_t stream) {
    static int grid = 0;
    if (grid == 0) {
        if (n_in != 21 || out_size != NLAT * DM || ws_size < WS_END) { fprintf(stderr, "kernel_launch: unexpected shapes (n_in %d out %d ws %zu need %zu)\n", n_in, out_size, ws_size, (size_t)WS_END); grid = -1; return; }
        int dev = 0, cus = 0, per_cu = 0;
        (void)hipGetDevice(&dev);
        (void)hipDeviceGetAttribute(&cus, hipDeviceAttributeMultiprocessorCount, dev);
        (void)hipFuncSetAttribute((const void*)fwd_megakernel, hipFuncAttributeMaxDynamicSharedMemorySize, LDS_BYTES);
        (void)hipOccupancyMaxActiveBlocksPerMultiprocessor(&per_cu, (const void*)fwd_megakernel, 512, LDS_BYTES);
        (void)hipGetLastError();
        if (per_cu < 1) fprintf(stderr, "kernel_launch: occupancy query says %d blocks per CU\n", per_cu);
        grid = cus;
    }
    if (grid < 0) return;
    Args a{};
    for (int i = 0; i < 21; ++i) a.in[i] = (const float*)d_in[i];
    a.out = (float*)d_out; a.ws = (unsigned char*)d_ws;
    void* kargs[] = {&a};
    hipError_t e = hipLaunchCooperativeKernel((const void*)fwd_megakernel, dim3(grid), dim3(512), kargs, LDS_BYTES, stream);
    if (e != hipSuccess) fprintf(stderr, "cooperative launch failed: %s (grid %d)\n", hipGetErrorString(e), grid);
}
```

```cpp
#include <hip/hip_runtime.h>
#include <hip/hip_cooperative_groups.h>
#include <cstdio>
#include <cstdint>
namespace cg = cooperative_groups;

#define LAS __attribute__((address_space(3)))
typedef unsigned short bf16_t;
typedef short bf16x8 __attribute__((ext_vector_type(8)));
typedef short s16x4 __attribute__((ext_vector_type(4)));
typedef float f32x4 __attribute__((ext_vector_type(4)));
typedef unsigned u32x4 __attribute__((ext_vector_type(4)));
typedef unsigned u32x2 __attribute__((ext_vector_type(2)));

constexpr int DM = 2048, SEQ = 4096, NLAT = 8192, NCTX = 512, MT = NLAT + NCTX, CTXL = 256;
constexpr int DFF = 5632, NMOD = 9 * DM;
constexpr int NSLOT = 34;
constexpr float LOG2E = 1.4426950408889634f;

constexpr size_t MiB = 1u << 20;
constexpr size_t WS_MOD = 0;
constexpr size_t WS_BAR = 256 * 1024;
constexpr size_t WS_ROPE = 512 * 1024;
constexpr size_t WS_W13A = 1 * MiB, WS_W2A = 45 * MiB, WS_W13B = 67 * MiB, WS_W2B = 111 * MiB, WS_WIN = 133 * MiB;
constexpr size_t WS_WOA = 177 * MiB, WS_WOB = 185 * MiB, WS_WOUT = 189 * MiB, WS_POOLW = 197 * MiB;
constexpr size_t WS_AN = 198 * MiB;
constexpr size_t WS_H = 232 * MiB;
constexpr size_t WS_HC1 = 326 * MiB;
constexpr size_t WS_K = 330 * MiB, WS_Q = 347 * MiB, WS_V = 363 * MiB, WS_G = 397 * MiB, WS_PIN = 429 * MiB, WS_GA = 445 * MiB, WS_GB = 477 * MiB;
constexpr size_t WS_POOLED = 509 * MiB, WS_PM = 525 * MiB, WS_END = 541 * MiB;
constexpr int LDS_BYTES = 147456;

__device__ __forceinline__ unsigned f2bf(float f) { unsigned u = __builtin_bit_cast(unsigned, f); return (u + 0x7fffu + ((u >> 16) & 1u)) >> 16; }
typedef float f32x2_t __attribute__((ext_vector_type(2))); typedef __bf16 bf16x2_t __attribute__((ext_vector_type(2)));
__device__ __forceinline__ unsigned pk2(float lo, float hi) { f32x2_t v = {lo, hi}; bf16x2_t b = __builtin_convertvector(v, bf16x2_t); return __builtin_bit_cast(unsigned, b); }
__device__ __forceinline__ float bflo(unsigned w) { return __builtin_bit_cast(float, w << 16); }
__device__ __forceinline__ float bfhi(unsigned w) { return __builtin_bit_cast(float, w & 0xffff0000u); }
__device__ __forceinline__ float bf1(short s) { return __builtin_bit_cast(float, ((unsigned)(unsigned short)s) << 16); }
__device__ __forceinline__ float fsilu(float a) { return a * __builtin_amdgcn_rcpf(1.0f + __builtin_amdgcn_exp2f(-a * LOG2E)); }
__device__ __forceinline__ float fsigm(float a) { return __builtin_amdgcn_rcpf(1.0f + __builtin_amdgcn_exp2f(-a * LOG2E)); }
__device__ __forceinline__ float wave_sum(float v) {
#pragma unroll
    for (int o = 1; o < 64; o <<= 1) v += __shfl_xor(v, o);
    return v;
}

namespace pg8 {
constexpr int BM = 256, BK = 64, HALF = 128, HTB = HALF * BK * 2, STAGE_BYTES = 8 * HTB, NXCD = 8, WGM = 8;
__device__ __forceinline__ int lds_byte(int r, int c) { const int st = (r >> 4) * 2 + (c >> 5), rr = r & 15, cc = c & 31, ob = rr * 64 + cc * 2; return st * 1024 + (ob ^ (((ob >> 9) & 1) << 5)); }
__device__ __forceinline__ void stage_rc(int b, int& R, int& C) { const int st = b / 1024, sb = b % 1024, swz = sb ^ (((sb >> 9) & 1) << 5); R = (st >> 1) * 16 + swz / 64; C = (st & 1) * 32 + (swz % 64) / 2; }
__device__ __forceinline__ int perm32(int rho) { const int n = rho >> 4, i = rho & 15; return 8 * (i >> 2) + 4 * n + (i & 3); }
struct Unit { int pm, pn, k0, nt; };
struct Gemm { const bf16_t* A; const bf16_t* Bt; int lda, ldb; };

struct MixOrder {
    int nMl, nN, nLat, nNc, nCtx, G, c, ntf, nsp, ntp;
    __device__ void init(int nMl_, int nN_, int nMc_, int nNc_, int G_, int c_, int ntf_, int nsp_ = 1) { nMl = nMl_; nN = nN_; nLat = nMl_ * nN_; nNc = nNc_; nsp = nsp_; nCtx = nMc_ * nNc_ * nsp_; G = G_; c = c_; ntf = ntf_; ntp = ntf_ / nsp_; }
    __device__ bool next(int i, Unit& u) const {
        long L = (long)i * G + c;
        if (L < nLat) {
            const int nwg = nLat, nM = nMl;
            int wgid = (int)L; { const int q = nwg / NXCD, r = nwg % NXCD, xcd = wgid % NXCD, off = wgid / NXCD; wgid = (xcd < r ? xcd * (q + 1) : r * (q + 1) + (xcd - r) * q) + off; }
            const int nig = WGM * nN, gid = wgid / nig, fm = gid * WGM, gsz = (nM - fm) < WGM ? (nM - fm) : WGM;
            u.pm = fm + ((wgid % nig) % gsz); u.pn = (wgid % nig) / gsz; u.k0 = 0; u.nt = ntf; return true;
        }
        L -= nLat;
        if (L < nCtx) { const int t = (int)(L / nsp), p = (int)(L % nsp); u.pm = nMl + t / nNc; u.pn = t % nNc; u.k0 = p * ntp; u.nt = ntp; return true; }
        return false;
    }
};

__device__ __forceinline__ unsigned cvt_pk_bf16(float lo, float hi) { return pk2(lo, hi); }
__device__ __forceinline__ u32x4 pack8(const f32x4 a, const f32x4 b) { u32x4 w; w.x = cvt_pk_bf16(a[0], a[1]); w.y = cvt_pk_bf16(a[2], a[3]); w.z = cvt_pk_bf16(b[0], b[1]); w.w = cvt_pk_bf16(b[2], b[3]); return w; }

struct EpiSwiglu {
    static constexpr bool PERM = true;
    bf16_t* O; int ldc;
    __device__ __forceinline__ void operator()(const f32x4 (&acc)[2][2][4][2], const Unit& u, int wr, int wc, int fr, int fq) const {
        const int row0 = u.pm * BM + wr * 64 + fr, col0 = u.pn * HALF + wc * 32 + 8 * fq;
#pragma unroll
        for (int ai = 0; ai < 2; ++ai)
#pragma unroll
            for (int m = 0; m < 4; ++m) {
                f32x4 h0, h1;
#pragma unroll
                for (int e = 0; e < 4; ++e) { h0[e] = fsilu(acc[ai][0][m][0][e]) * acc[ai][1][m][0][e]; h1[e] = fsilu(acc[ai][0][m][1][e]) * acc[ai][1][m][1][e]; }
                *(u32x4*)(O + (size_t)(row0 + ai * HALF + m * 16) * ldc + col0) = pack8(h0, h1);
            }
    }
};
struct EpiResid {
    static constexpr bool PERM = false;
    const float* res_lat; float* out_lat; float* out_ctx; const float* mod; int gidx; float scale;
    __device__ __forceinline__ void operator()(const f32x4 (&acc)[2][2][4][2], const Unit& u, int wr, int wc, int fr, int fq) const {
        const bool ctx = u.pm >= 32; const int bsel = ctx ? 2 : (u.pm >= 16 ? 1 : 0);
        const int row0 = (ctx ? (u.pm - 32) : u.pm) * BM + wr * 64 + fr, col0 = u.pn * BM + wc * 32 + 4 * fq;
        const float* gate = mod + bsel * NMOD + gidx * DM;
        f32x4 gv[2][2];
#pragma unroll
        for (int bj = 0; bj < 2; ++bj)
#pragma unroll
            for (int n = 0; n < 2; ++n) gv[bj][n] = *(const f32x4*)(gate + col0 + bj * HALF + n * 16) * scale;
        if (!ctx) {
#pragma unroll
            for (int ai = 0; ai < 2; ++ai)
#pragma unroll
                for (int m = 0; m < 4; ++m) { const size_t off = (size_t)(row0 + ai * HALF + m * 16) * DM + col0;
#pragma unroll
                    for (int bj = 0; bj < 2; ++bj)
#pragma unroll
                        for (int n = 0; n < 2; ++n) { const size_t o = off + bj * HALF + n * 16; const f32x4 r = *(const f32x4*)(res_lat + o); *(f32x4*)(out_lat + o) = r + gv[bj][n] * acc[ai][bj][m][n]; } }
        } else {
#pragma unroll
            for (int ai = 0; ai < 2; ++ai)
#pragma unroll
                for (int m = 0; m < 4; ++m) { const size_t off = (size_t)(row0 + ai * HALF + m * 16) * DM + col0;
#pragma unroll
                    for (int bj = 0; bj < 2; ++bj)
#pragma unroll
                        for (int n = 0; n < 2; ++n) { const f32x4 v = gv[bj][n] * acc[ai][bj][m][n]; float* p = out_ctx + off + bj * HALF + n * 16;
#pragma unroll
                            for (int e = 0; e < 4; ++e) __hip_atomic_fetch_add(p + e, v[e], __ATOMIC_RELAXED, __HIP_MEMORY_SCOPE_AGENT); } }
        }
    }
};
struct EpiIn {
    static constexpr bool PERM = true;
    bf16_t *K, *Q, *V, *G, *PIN, *GA, *GB; const float* bgate; const float* rope;
    __device__ __forceinline__ void operator()(const f32x4 (&acc)[2][2][4][2], const Unit& u, int wr, int wc, int fr, int fq) const {
        const int row0 = u.pm * BM + wr * 64 + fr, cb = wc * 32 + 8 * fq, pn = u.pn;
        if (pn < 4 || (pn >= 12 && pn < 16)) {
            const bool isk = pn < 4; bf16_t* dst = isk ? K : Q; const int hcol = (isk ? pn : pn - 12) * BM; const float sc = isk ? 0.08838834764831845f : 1.0f;
            const bool lat = u.pm < 32; const int i0 = (16 * wc + 4 * fq) & 31;
#pragma unroll
            for (int ai = 0; ai < 2; ++ai)
#pragma unroll
                for (int m = 0; m < 4; ++m) {
                    const int row = row0 + ai * HALF + m * 16;
                    f32x4 cs0 = {1.f, 0.f, 1.f, 0.f}, cs1 = {1.f, 0.f, 1.f, 0.f};
                    if (lat) { const int t = row & 4095; const int pos = (wc < 2) ? (t >> 6) : (t & 63); const float* rp = rope + (pos * 32 + i0) * 2; cs0 = *(const f32x4*)rp; cs1 = *(const f32x4*)(rp + 4); }
                    const float c_[4] = {cs0[0], cs0[2], cs1[0], cs1[2]}, s_[4] = {cs0[1], cs0[3], cs1[1], cs1[3]};
#pragma unroll
                    for (int bj = 0; bj < 2; ++bj) { const f32x4 x1 = acc[ai][bj][m][0], x2 = acc[ai][bj][m][1]; f32x4 o1, o2;
#pragma unroll
                        for (int e = 0; e < 4; ++e) { o1[e] = (x1[e] * c_[e] - x2[e] * s_[e]) * sc; o2[e] = (x1[e] * s_[e] + x2[e] * c_[e]) * sc; }
                        *(u32x4*)(dst + (size_t)row * 1024 + hcol + bj * HALF + cb) = pack8(o1, o2); }
                }
        } else if (pn < 12) {
#pragma unroll
            for (int ai = 0; ai < 2; ++ai)
#pragma unroll
                for (int m = 0; m < 4; ++m)
#pragma unroll
                    for (int bj = 0; bj < 2; ++bj) *(u32x4*)(V + (size_t)(row0 + ai * HALF + m * 16) * DM + (pn - 4) * BM + bj * HALF + cb) = pack8(acc[ai][bj][m][0], acc[ai][bj][m][1]);
        } else if (pn < 24) {
#pragma unroll
            for (int ai = 0; ai < 2; ++ai)
#pragma unroll
                for (int m = 0; m < 4; ++m)
#pragma unroll
                    for (int bj = 0; bj < 2; ++bj) { f32x4 a = acc[ai][bj][m][0], b = acc[ai][bj][m][1];
#pragma unroll
                        for (int e = 0; e < 4; ++e) { a[e] = fsilu(a[e]); b[e] = fsilu(b[e]); }
                        *(u32x4*)(G + (size_t)(row0 + ai * HALF + m * 16) * DM + (pn - 16) * BM + bj * HALF + cb) = pack8(a, b); }
        } else if (pn < 28) {
#pragma unroll
            for (int ai = 0; ai < 2; ++ai)
#pragma unroll
                for (int m = 0; m < 4; ++m)
#pragma unroll
                    for (int bj = 0; bj < 2; ++bj) *(u32x4*)(PIN + (size_t)(row0 + ai * HALF + m * 16) * 1024 + (pn - 24) * BM + bj * HALF + cb) = pack8(acc[ai][bj][m][0], acc[ai][bj][m][1]);
        } else {
            const int gc = (pn - 28) * BM; bf16_t* dst = gc < DM ? GA : GB; const int dc = gc < DM ? gc : gc - DM;
#pragma unroll
            for (int bj = 0; bj < 2; ++bj) { const f32x4 b0 = *(const f32x4*)(bgate + gc + bj * HALF + cb), b1 = *(const f32x4*)(bgate + gc + bj * HALF + cb + 4);
#pragma unroll
                for (int ai = 0; ai < 2; ++ai)
#pragma unroll
                    for (int m = 0; m < 4; ++m) { f32x4 a = acc[ai][bj][m][0] + b0, b = acc[ai][bj][m][1] + b1;
#pragma unroll
                        for (int e = 0; e < 4; ++e) { a[e] = fsigm(a[e]); b[e] = fsigm(b[e]); }
                        *(u32x4*)(dst + (size_t)(row0 + ai * HALF + m * 16) * DM + dc + bj * HALF + cb) = pack8(a, b); } }
        }
    }
};
struct EpiMergeA {
    static constexpr bool PERM = true;
    float* T1; const bf16_t* GA;
    __device__ __forceinline__ void operator()(const f32x4 (&acc)[2][2][4][2], const Unit& u, int wr, int wc, int fr, int fq) const {
        const int row0 = u.pm * BM + wr * 64 + fr, col0 = u.pn * BM + wc * 32 + 8 * fq;
#pragma unroll
        for (int ai = 0; ai < 2; ++ai)
#pragma unroll
            for (int m = 0; m < 4; ++m)
#pragma unroll
                for (int bj = 0; bj < 2; ++bj) { const size_t o = (size_t)(row0 + ai * HALF + m * 16) * DM + col0 + bj * HALF; const u32x4 g = *(const u32x4*)(GA + o);
                    const f32x4 g0 = {bflo(g.x), bfhi(g.x), bflo(g.y), bfhi(g.y)}, g1 = {bflo(g.z), bfhi(g.z), bflo(g.w), bfhi(g.w)};
                    *(f32x4*)(T1 + o) = g0 * acc[ai][bj][m][0]; *(f32x4*)(T1 + o + 4) = g1 * acc[ai][bj][m][1]; }
    }
};
struct EpiMergeB {
    static constexpr bool PERM = true;
    const float* T1; const bf16_t* GB; bf16_t* MM;
    __device__ __forceinline__ void operator()(const f32x4 (&acc)[2][2][4][2], const Unit& u, int wr, int wc, int fr, int fq) const {
        const int row0 = u.pm * BM + wr * 64 + fr, col0 = u.pn * BM + wc * 32 + 8 * fq;
#pragma unroll
        for (int ai = 0; ai < 2; ++ai)
#pragma unroll
            for (int m = 0; m < 4; ++m)
#pragma unroll
                for (int bj = 0; bj < 2; ++bj) { const size_t o = (size_t)(row0 + ai * HALF + m * 16) * DM + col0 + bj * HALF; const u32x4 g = *(const u32x4*)(GB + o);
                    const f32x4 g0 = {bflo(g.x), bfhi(g.x), bflo(g.y), bfhi(g.y)}, g1 = {bflo(g.z), bfhi(g.z), bflo(g.w), bfhi(g.w)};
                    const f32x4 t0 = *(const f32x4*)(T1 + o), t1 = *(const f32x4*)(T1 + o + 4);
                    *(u32x4*)(MM + o) = pack8(t0 + g0 * acc[ai][bj][m][0], t1 + g1 * acc[ai][bj][m][1]); }
    }
};
struct EpiPool {
    static constexpr bool PERM = true;
    bf16_t* PM; const float* pscale; int g;
    __device__ __forceinline__ void operator()(const f32x4 (&acc)[2][2][4][2], const Unit& u, int wr, int wc, int fr, int fq) const {
        const int row0 = u.pm * BM + wr * 64 + fr, col0 = g * BM + wc * 32 + 8 * fq;
#pragma unroll
        for (int bj = 0; bj < 2; ++bj) { const f32x4 s0 = *(const f32x4*)(pscale + col0 + bj * HALF), s1 = *(const f32x4*)(pscale + col0 + bj * HALF + 4);
#pragma unroll
            for (int ai = 0; ai < 2; ++ai)
#pragma unroll
                for (int m = 0; m < 4; ++m) *(u32x4*)(PM + (size_t)(row0 + ai * HALF + m * 16) * 1024 + col0 + bj * HALF) = pack8(acc[ai][bj][m][0] * s0, acc[ai][bj][m][1] * s1); }
    }
};

template <class Epi, class Sched, bool ALIGN_EPI>
__device__ __forceinline__ void gemm_phase(LAS unsigned char* lds, const Gemm g, const Sched& S, const Epi& E) {
    int tid = threadIdx.x; asm volatile("" : "+v"(tid));
    const int wid = __builtin_amdgcn_readfirstlane(tid >> 6), lane = tid & 63, wr = wid >> 2, wc = wid & 3, fr = lane & 15, fq = lane >> 4;
    unsigned voffA[2], voffB[2];
#pragma unroll
    for (int i = 0; i < 2; ++i) { int R, C; stage_rc(tid * 16 + i * 8192, R, C); const int Rb = Epi::PERM ? ((R & ~31) + perm32(R & 31)) : R;
        voffA[i] = (unsigned)(R * g.lda + C) * 2u; voffB[i] = (unsigned)(Rb * g.ldb + C) * 2u; }
    const size_t kstep = (size_t)(BK * 2);
    const size_t hstepA = (size_t)HALF * g.lda * 2, hstepB = (size_t)HALF * g.ldb * 2;
    const size_t tstepA = 2 * hstepA, tstepB = 2 * hstepB;
    const unsigned ldsw = (unsigned)wid * 1024u;
    const int aoff = lds_byte(wr * 64 + fr, fq * 8), boff = lds_byte(wc * 32 + fr, fq * 8);
#define PG8_SA(b, h) (((b) * 2 + (h)) * HTB)
#define PG8_SB(b, h) ((4 + (b) * 2 + (h)) * HTB)
#define PG8_STAGE(bufoff, gbase, voff) do { _Pragma("unroll") for (int _i = 0; _i < 2; ++_i) \
        __builtin_amdgcn_global_load_lds((const unsigned*)((const char*)(gbase) + (voff)[_i]), (LAS unsigned*)(lds + (bufoff) + ldsw + _i * 8192), 16, 0, 0); } while (0)
#define PG8_LDA(dst, b, h) do { _Pragma("unroll") for (int m = 0; m < 4; ++m) _Pragma("unroll") for (int k = 0; k < 2; ++k) dst[m][k] = *(const LAS bf16x8*)(lds + PG8_SA(b, h) + aoff + m * 2048 + k * 1024); } while (0)
#define PG8_LDB(dst, b, h) do { _Pragma("unroll") for (int n = 0; n < 2; ++n) _Pragma("unroll") for (int k = 0; k < 2; ++k) dst[n][k] = *(const LAS bf16x8*)(lds + PG8_SB(b, h) + boff + n * 2048 + k * 1024); } while (0)
#define PG8_MMA(ai, bj, At, Bt) do { __builtin_amdgcn_s_setprio(1); _Pragma("unroll") for (int m = 0; m < 4; ++m) _Pragma("unroll") for (int n = 0; n < 2; ++n) _Pragma("unroll") for (int k = 0; k < 2; ++k) \
        acc[ai][bj][m][n] = __builtin_amdgcn_mfma_f32_16x16x32_bf16(Bt[n][k], At[m][k], acc[ai][bj][m][n], 0, 0, 0); __builtin_amdgcn_s_setprio(0); } while (0)
#define PG8_WAIT_V(n) asm volatile("s_waitcnt vmcnt(" #n ")" ::: "memory")
#define PG8_WAIT_L(n) asm volatile("s_waitcnt lgkmcnt(" #n ")" ::: "memory")
#define PG8_BAR __builtin_amdgcn_s_barrier()
#define PG8_SCHED __builtin_amdgcn_sched_barrier(0)
    Unit cur, nxt; int ui = 0;
    if (!S.next(0, cur)) return;
    f32x4 acc[2][2][4][2];
#pragma unroll
    for (int a = 0; a < 2; ++a)
#pragma unroll
        for (int b = 0; b < 2; ++b)
#pragma unroll
            for (int m = 0; m < 4; ++m)
#pragma unroll
                for (int n = 0; n < 2; ++n) acc[a][b][m][n] = (f32x4){0.f, 0.f, 0.f, 0.f};
    bf16x8 At[4][2], B0[2][2], B1[2][2];
    const char* cA = (const char*)g.A + (size_t)cur.pm * tstepA + (size_t)cur.k0 * kstep; const char* cB = (const char*)g.Bt + (size_t)cur.pn * tstepB + (size_t)cur.k0 * kstep;
    PG8_STAGE(PG8_SB(0, 0), cB, voffB); PG8_STAGE(PG8_SB(0, 1), cB + hstepB, voffB); PG8_STAGE(PG8_SA(0, 0), cA, voffA); PG8_STAGE(PG8_SA(0, 1), cA + hstepA, voffA);
    if (wr == 1) PG8_BAR;
    PG8_WAIT_V(2); PG8_BAR;
    PG8_STAGE(PG8_SB(1, 0), cB + kstep, voffB); PG8_STAGE(PG8_SA(1, 0), cA + kstep, voffA); PG8_STAGE(PG8_SB(1, 1), cB + hstepB + kstep, voffB);
    PG8_WAIT_V(6); PG8_BAR;
    for (;;) {
        const bool has_next = S.next(ui + 1, nxt);
        const char* nA = has_next ? (const char*)g.A + (size_t)nxt.pm * tstepA + (size_t)nxt.k0 * kstep : cA; const char* nB = has_next ? (const char*)g.Bt + (size_t)nxt.pn * tstepB + (size_t)nxt.k0 * kstep : cB;
        const int nt = cur.nt;
#pragma unroll 1
        for (int t = 0; t < nt; t += 2) {
            const bool last = (t == nt - 2);
            const char* a1 = cA + (size_t)(t + 1) * kstep;
            const char* a2 = last ? nA : cA + (size_t)(t + 2) * kstep; const char* b2 = last ? nB : cB + (size_t)(t + 2) * kstep;
            const char* a3 = a2 + kstep; const char* b3 = b2 + kstep;
            PG8_LDB(B0, 0, 0); PG8_LDB(B1, 0, 1); PG8_SCHED; PG8_LDA(At, 0, 0); PG8_STAGE(PG8_SA(1, 1), a1 + hstepA, voffA);
            PG8_WAIT_V(8); PG8_WAIT_L(0); PG8_BAR; PG8_MMA(0, 0, At, B0); PG8_MMA(0, 1, At, B1); PG8_BAR; PG8_SCHED;
            PG8_LDA(At, 0, 1); PG8_STAGE(PG8_SB(0, 0), b2, voffB); PG8_STAGE(PG8_SB(0, 1), b2 + hstepB, voffB); PG8_STAGE(PG8_SA(0, 0), a2, voffA);
            PG8_WAIT_V(8); PG8_WAIT_L(0); PG8_BAR; PG8_MMA(1, 0, At, B0); PG8_MMA(1, 1, At, B1); PG8_BAR; PG8_SCHED;
            PG8_LDB(B0, 1, 0); PG8_LDB(B1, 1, 1); PG8_SCHED; PG8_LDA(At, 1, 0); PG8_STAGE(PG8_SA(0, 1), a2 + hstepA, voffA);
            PG8_WAIT_V(8); PG8_WAIT_L(0); PG8_BAR; PG8_MMA(0, 0, At, B0); PG8_MMA(0, 1, At, B1); PG8_BAR; PG8_SCHED;
            PG8_LDA(At, 1, 1); PG8_STAGE(PG8_SB(1, 0), b3, voffB); PG8_STAGE(PG8_SB(1, 1), b3 + hstepB, voffB); PG8_STAGE(PG8_SA(1, 0), a3, voffA);
            PG8_WAIT_V(8); PG8_WAIT_L(0); PG8_BAR; PG8_MMA(1, 0, At, B0); PG8_MMA(1, 1, At, B1); PG8_BAR; PG8_SCHED;
        }
        if constexpr (ALIGN_EPI) { if (wr == 0) PG8_BAR; }
        E(acc, cur, wr, wc, fr, fq);
        if (!has_next) break;
#pragma unroll
        for (int a = 0; a < 2; ++a)
#pragma unroll
            for (int b = 0; b < 2; ++b)
#pragma unroll
                for (int m = 0; m < 4; ++m)
#pragma unroll
                    for (int n = 0; n < 2; ++n) acc[a][b][m][n] = (f32x4){0.f, 0.f, 0.f, 0.f};
        cur = nxt; cA = nA; cB = nB; ++ui;
        if constexpr (ALIGN_EPI) { if (wr == 1) PG8_BAR; }
    }
    PG8_WAIT_V(0);
    if constexpr (!ALIGN_EPI) { if (wr == 0) PG8_BAR; }
    PG8_BAR;
#undef PG8_SA
#undef PG8_SB
#undef PG8_STAGE
#undef PG8_LDA
#undef PG8_LDB
#undef PG8_MMA
#undef PG8_WAIT_V
#undef PG8_WAIT_L
#undef PG8_BAR
#undef PG8_SCHED
}
}


#define XB_TMO      128
#define XB_XCNT(j)  (256  + 64 * (j))
#define XB_XSUB(j)  (1280 + 64 * (j))
#define XB_XGEN(j)  (2304 + 64 * (j))
#define XB_TOP      3328
#define XB_TOPGEN   3392
#define XCD_BAR_WORDS 3456
#define XB_SPIN_CAP (1u << 18)
__device__ __forceinline__ unsigned xb_ld(unsigned* p)              { return __hip_atomic_load(p, __ATOMIC_RELAXED, __HIP_MEMORY_SCOPE_AGENT); }
__device__ __forceinline__ unsigned xb_add(unsigned* p, unsigned v) { return __hip_atomic_fetch_add(p, v, __ATOMIC_RELAXED, __HIP_MEMORY_SCOPE_AGENT); }
__device__ __forceinline__ unsigned xb_xcc_id() { return (unsigned)__builtin_amdgcn_s_getreg((3 << 11) | 20) & 0xFu; }
#define XB_SPIN(cond, bar) do { unsigned _sp = 0; while (cond) { __builtin_amdgcn_s_sleep(1); \
    if ((++_sp & 255u) == 0u) { if (xb_ld(&(bar)[XB_TMO])) break; if (_sp > XB_SPIN_CAP) { atomicAdd(&(bar)[XB_TMO], 1u); break; } } } } while (0)
struct XcdBarrier { unsigned* bar; unsigned x; volatile LAS unsigned* st; };
__device__ __forceinline__ XcdBarrier xcd_barrier_post(unsigned* bar, volatile LAS unsigned* st) {
    XcdBarrier b; b.bar = bar; b.x = xb_xcc_id(); b.st = st;
    if (threadIdx.x == 0) (void)xb_add(&bar[XB_XCNT(b.x)], 1u);
    return b;
}
__device__ __forceinline__ void xcd_barrier_complete(unsigned* bar, unsigned x, unsigned& nloc, unsigned& nx) {
    const unsigned G = gridDim.x * gridDim.y * gridDim.z;
    unsigned sum, cnt, mine, sp = 0u;
    for (;;) {
        sum = 0u; cnt = 0u; mine = 0u;
#pragma unroll
        for (unsigned j = 0; j < 16; ++j) { const unsigned c = xb_ld(&bar[XB_XCNT(j)]); sum += c; cnt += (c > 0u) ? 1u : 0u; mine = (j == x) ? c : mine; }
        if (sum == G) break;
        __builtin_amdgcn_s_sleep(1);
        if ((++sp & 255u) == 0u) { if (xb_ld(&bar[XB_TMO])) break; if (sp > XB_SPIN_CAP) { atomicAdd(&bar[XB_TMO], 1u); break; } }
    }
    nloc = mine > 0u ? mine : 1u; nx = cnt > 0u ? cnt : 1u;
}
__device__ __forceinline__ void xcd_barrier(const XcdBarrier& b) {
    asm volatile("s_waitcnt vmcnt(0)" ::: "memory");
    __syncthreads();
    if (threadIdx.x == 0) {
        unsigned* bar = b.bar;
        __builtin_amdgcn_s_waitcnt(0);
        unsigned nloc = b.st[0], nx = b.st[1];
        if (nloc == 0u) { xcd_barrier_complete(bar, b.x, nloc, nx); b.st[0] = nloc; b.st[1] = nx; }
        const unsigned old = xb_add(&bar[XB_XSUB(b.x)], 1u);
        const unsigned gen = old / nloc;
        if (old + 1u == (gen + 1u) * nloc) {
            __builtin_amdgcn_fence(__ATOMIC_RELEASE, "agent");
            asm volatile("s_waitcnt vmcnt(0)" ::: "memory");
            const unsigned og = xb_add(&bar[XB_TOP], 1u);
            const unsigned tg = og / nx;
            if (og + 1u == (tg + 1u) * nx) xb_add(&bar[XB_TOPGEN], 1u);
            else XB_SPIN(xb_ld(&bar[XB_TOPGEN]) == tg, bar);
            __builtin_amdgcn_fence(__ATOMIC_ACQUIRE, "agent");
            xb_add(&bar[XB_XGEN(b.x)], 1u);
            asm volatile("s_waitcnt vmcnt(0)" ::: "memory");
        } else {
            XB_SPIN(xb_ld(&bar[XB_XGEN(b.x)]) == gen, bar);
            __builtin_amdgcn_fence(__ATOMIC_ACQUIRE, "agent");
            asm volatile("s_waitcnt vmcnt(0)" ::: "memory");
        }
    }
    __syncthreads();
}
struct Args { const float* in[21]; float* out; unsigned char* ws; int pad0, pad1; };
#define LDS_WAIT() asm volatile("s_waitcnt lgkmcnt(0)" ::: "memory")
#define GRID_SYNC() xcd_barrier(xbar)

__device__ __forceinline__ int dest_row(int mode, int n) {
    if (mode == 1) { const int half = n >= DFF ? 1 : 0; const int j = n - half * DFF; return ((j >> 7) << 8) + (half << 7) + (j & 127); }
    if (mode == 2) { if (n < 1024 || (n >= 3072 && n < 4096)) { const int d = n & 127, half = d >> 6, dd = d & 63, i = dd & 31, nb = dd >> 5, rho = 32 * half + i;
            return (n & ~127) + 32 * (rho >> 4) + 8 * ((rho >> 2) & 3) + 4 * nb + (rho & 3); } return n; }
    return n;
}
__device__ __forceinline__ void tr_item(const float* W, int K, int N, bf16_t* WT, int row_off, int mode, LAS float* scr, int item, int lane) {
    const int nblk = N >> 6, kb = item / nblk, nb = item - kb * nblk, k0 = kb << 6, n0 = nb << 6;
    f32x4 v[16];
#pragma unroll
    for (int i = 0; i < 16; ++i) { const int idx = i * 64 + lane, kk = idx >> 4, c4 = idx & 15; v[i] = *(const f32x4*)(W + (size_t)(k0 + kk) * N + n0 + 4 * c4); }
#pragma unroll
    for (int i = 0; i < 16; ++i) { const int idx = i * 64 + lane, kk = idx >> 4, c4 = idx & 15; LAS float* s = scr + kk * 65 + 4 * c4; s[0] = v[i][0]; s[1] = v[i][1]; s[2] = v[i][2]; s[3] = v[i][3]; }
    LDS_WAIT(); asm volatile("" ::: "memory");
    const int c = lane & 7;
#pragma unroll
    for (int j = 0; j < 8; ++j) { const int n = (lane >> 3) + 8 * j; const LAS float* s = scr + (8 * c) * 65 + n;
        u32x4 o; o.x = pk2(s[0], s[65]); o.y = pk2(s[2 * 65], s[3 * 65]); o.z = pk2(s[4 * 65], s[5 * 65]); o.w = pk2(s[6 * 65], s[7 * 65]);
        *(u32x4*)(WT + (size_t)(row_off + dest_row(mode, n0 + n)) * K + k0 + 8 * c) = o; }
    LDS_WAIT(); asm volatile("" ::: "memory");
}

__device__ __forceinline__ void norm_rows(const float* src_lat, const float* src_ctx, int nrows, const float* gvec, const float* mod, int shidx, int scidx, bf16_t* dst, int gw, int NGW, int lane) {
    for (int r = gw; r < nrows; r += NGW) {
        const float* src = r < NLAT ? src_lat + (size_t)r * DM : src_ctx + (size_t)(r - NLAT) * DM;
        const int bsel = r < SEQ ? 0 : (r < NLAT ? 1 : 2);
        const f32x4* s4 = (const f32x4*)src + lane;
        f32x4 v[8]; float ss = 0.f;
#pragma unroll
        for (int j = 0; j < 8; ++j) { v[j] = s4[64 * j]; ss += (v[j][0] * v[j][0] + v[j][1] * v[j][1]) + (v[j][2] * v[j][2] + v[j][3] * v[j][3]); }
        const float rstd = 1.0f / sqrtf(wave_sum(ss) * (1.0f / DM) + 1e-6f);
        const f32x4* g4 = (const f32x4*)gvec + lane; const f32x4* sc4 = (const f32x4*)(mod + bsel * NMOD + scidx * DM) + lane; const f32x4* sh4 = (const f32x4*)(mod + bsel * NMOD + shidx * DM) + lane;
        u32x2* o8 = (u32x2*)(dst + (size_t)r * DM) + lane;
#pragma unroll
        for (int j = 0; j < 8; ++j) { const f32x4 y = v[j] * rstd * g4[64 * j]; const f32x4 o = y * (sc4[64 * j] + 1.0f) + sh4[64 * j]; u32x2 w; w.x = pk2(o[0], o[1]); w.y = pk2(o[2], o[3]); o8[64 * j] = w; }
    }
}

__device__ __forceinline__ s16x4 lds_tr(const LAS unsigned char* p) { return __builtin_amdgcn_ds_read_tr16_b64_v4i16((LAS s16x4*)p); }
__device__ __forceinline__ bf16x8 lds_tr8(const LAS unsigned char* base, int pitch, int k0, int n0, int lane) {
    const int g = lane >> 4, q = (lane & 15) >> 2, p = lane & 3;
    const LAS unsigned char* a = base + (k0 + 8 * g + q) * pitch + (n0 + 4 * p) * 2;
    const s16x4 lo = lds_tr(a), hi = lds_tr(a + 4 * pitch);
    return (bf16x8){lo[0], lo[1], lo[2], lo[3], hi[0], hi[1], hi[2], hi[3]};
}
__device__ __forceinline__ float log2_gamma(const float* decay_logit, int dir, int h) { const float x = decay_logit[dir * 8 + h]; return -log1pf(expf(-x)) * LOG2E; }
__device__ __forceinline__ int slot_row0(int b, int slot) { return slot < 2 ? NLAT + b * CTXL + slot * 128 : b * SEQ + (slot - 2) * 128; }

__device__ __forceinline__ void r1_task(LAS unsigned char* lds, int task, const bf16_t* Kg, const bf16_t* Vg, bf16_t* KVS, const float* decay_logit) {
    int tid = threadIdx.x; asm volatile("" : "+v"(tid));
    const int lane = tid & 63, w = tid >> 6, g = lane >> 4, r16 = lane & 15;
    const int bh = task / NSLOT, slot = task - bh * NSLOT, b = bh >> 3, h = bh & 7, row0 = slot_row0(b, slot);
    const float l2f = log2_gamma(decay_logit, 0, h), l2b = log2_gamma(decay_logit, 1, h);
    LAS unsigned char* VS = lds; LAS unsigned char* KF = lds + 67584; LAS unsigned char* KB = lds + 67584 + 34816;
#pragma unroll
    for (int it = 0; it < 8; ++it) { const int p = tid + it * 512, r = p >> 5, cc = p & 31; *(LAS u32x4*)(VS + r * 528 + cc * 16) = *(const u32x4*)(Vg + (size_t)(row0 + r) * DM + h * 256 + cc * 8); }
#pragma unroll
    for (int it = 0; it < 4; ++it) { const int p = tid + it * 512, r = p >> 4, cc = p & 15; const u32x4 kv = *(const u32x4*)(Kg + (size_t)(row0 + r) * 1024 + h * 128 + cc * 8);
        const float wf = __builtin_amdgcn_exp2f(l2f * (float)(127 - r)), wb = __builtin_amdgcn_exp2f(l2b * (float)r);
        u32x4 of, ob;
        of.x = pk2(bflo(kv.x) * wf, bfhi(kv.x) * wf); of.y = pk2(bflo(kv.y) * wf, bfhi(kv.y) * wf); of.z = pk2(bflo(kv.z) * wf, bfhi(kv.z) * wf); of.w = pk2(bflo(kv.w) * wf, bfhi(kv.w) * wf);
        ob.x = pk2(bflo(kv.x) * wb, bfhi(kv.x) * wb); ob.y = pk2(bflo(kv.y) * wb, bfhi(kv.y) * wb); ob.z = pk2(bflo(kv.z) * wb, bfhi(kv.z) * wb); ob.w = pk2(bflo(kv.w) * wb, bfhi(kv.w) * wb);
        *(LAS u32x4*)(KF + r * 272 + cc * 16) = of; *(LAS u32x4*)(KB + r * 272 + cc * 16) = ob; }
    __syncthreads();
#pragma unroll 1
    for (int dir = 0; dir < 2; ++dir) {
        const LAS unsigned char* KW = dir == 0 ? KF : KB;
        f32x4 af[8][2];
#pragma unroll
        for (int mb = 0; mb < 8; ++mb)
#pragma unroll
            for (int nb = 0; nb < 2; ++nb) af[mb][nb] = (f32x4){0.f, 0.f, 0.f, 0.f};
#pragma unroll
        for (int ks = 0; ks < 4; ++ks) {
            bf16x8 bv[2];
#pragma unroll
            for (int nb = 0; nb < 2; ++nb) bv[nb] = lds_tr8(VS, 528, 32 * ks, 32 * w + 16 * nb, lane);
#pragma unroll
            for (int mb = 0; mb < 8; ++mb) { const bf16x8 kf = lds_tr8(KW, 272, 32 * ks, 16 * mb, lane);
#pragma unroll
                for (int nb = 0; nb < 2; ++nb) af[mb][nb] = __builtin_amdgcn_mfma_f32_16x16x32_bf16(kf, bv[nb], af[mb][nb], 0, 0, 0); }
            __builtin_amdgcn_sched_barrier(0);
        }
        bf16_t* of_ = KVS + ((size_t)(bh * NSLOT + slot) * 2 + dir) * 32768;
#pragma unroll
        for (int mb = 0; mb < 8; ++mb)
#pragma unroll
            for (int nb = 0; nb < 2; ++nb) { const int e = 32 * w + 16 * nb + r16, d = 16 * mb + 4 * g; u32x2 o;
                o.x = pk2(af[mb][nb][0], af[mb][nb][1]); o.y = pk2(af[mb][nb][2], af[mb][nb][3]); *(u32x2*)(of_ + e * 128 + d) = o; }
    }
    __syncthreads();
}

__device__ __forceinline__ void r3_task(LAS unsigned char* lds, int task, const bf16_t* Qg, const bf16_t* Kg, const bf16_t* Vg, const bf16_t* KVS, const bf16_t* Gs, bf16_t* ZA, const float* decay_logit) {
    int tid = threadIdx.x; asm volatile("" : "+v"(tid));
    const int lane = tid & 63, w = tid >> 6, g = lane >> 4, r16 = lane & 15;
    const int bh = task >> 5, c = task & 31, b = bh >> 3, h = bh & 7, row0 = b * SEQ + c * 128;
    const float l2f = log2_gamma(decay_logit, 0, h), l2b = log2_gamma(decay_logit, 1, h);
    LAS unsigned char* QS = lds; LAS unsigned char* KS = lds + 34816; LAS unsigned char* CS = lds + 69632;
#pragma unroll
    for (int it = 0; it < 4; ++it) { const int p = tid + it * 512, r = p >> 4, cc = p & 15;
        *(LAS u32x4*)(QS + r * 272 + cc * 16) = *(const u32x4*)(Qg + (size_t)(row0 + r) * 1024 + h * 128 + cc * 8);
        *(LAS u32x4*)(KS + r * 272 + cc * 16) = *(const u32x4*)(Kg + (size_t)(row0 + r) * 1024 + h * 128 + cc * 8); }
#pragma unroll
    for (int it = 0; it < 8; ++it) { const int p = tid + it * 512, r = p >> 5, cc = p & 31; *(LAS u32x4*)(CS + r * 528 + cc * 16) = *(const u32x4*)(Vg + (size_t)(row0 + r) * DM + h * 256 + cc * 8); }
    __syncthreads();
    f32x4 pa[8];
#pragma unroll
    for (int mb = 0; mb < 8; ++mb) pa[mb] = (f32x4){0.f, 0.f, 0.f, 0.f};
    bf16x8 qf[4];
#pragma unroll
    for (int ks = 0; ks < 4; ++ks) qf[ks] = *(const LAS bf16x8*)(QS + (16 * w + r16) * 272 + (32 * ks + 8 * g) * 2);
#pragma unroll
    for (int ks = 0; ks < 4; ++ks)
#pragma unroll
        for (int mb = 0; mb < 8; ++mb) { const bf16x8 kf = *(const LAS bf16x8*)(KS + (16 * mb + r16) * 272 + (32 * ks + 8 * g) * 2); pa[mb] = __builtin_amdgcn_mfma_f32_16x16x32_bf16(kf, qf[ks], pa[mb], 0, 0, 0); }
    {   const int i = 16 * w + r16;
#pragma unroll
        for (int mb = 0; mb < 8; ++mb)
#pragma unroll
            for (int jj = 0; jj < 4; ++jj) { const int j = 16 * mb + 4 * g + jj; const int dd = i - j;
                const float f = dd > 0 ? __builtin_amdgcn_exp2f(l2f * (float)dd) : (dd < 0 ? __builtin_amdgcn_exp2f(l2b * (float)(-dd)) : 2.0f); pa[mb][jj] *= f; }
    }
    __syncthreads();
#pragma unroll
    for (int mb = 0; mb < 8; ++mb) { u32x2 o; o.x = pk2(pa[mb][0], pa[mb][1]); o.y = pk2(pa[mb][2], pa[mb][3]); *(LAS u32x2*)(KS + (16 * w + r16) * 272 + (16 * mb + 4 * g) * 2) = o; }
    LDS_WAIT(); asm volatile("" ::: "memory");
    f32x4 acc[16];
#pragma unroll
    for (int nb = 0; nb < 16; ++nb) acc[nb] = (f32x4){0.f, 0.f, 0.f, 0.f};
#pragma unroll
    for (int ks = 0; ks < 4; ++ks) { const bf16x8 pf = *(const LAS bf16x8*)(KS + (16 * w + r16) * 272 + (32 * ks + 8 * g) * 2);
#pragma unroll
        for (int nb = 0; nb < 16; ++nb) { const bf16x8 vf = lds_tr8(CS, 528, 32 * ks, 16 * nb, lane); acc[nb] = __builtin_amdgcn_mfma_f32_16x16x32_bf16(pf, vf, acc[nb], 0, 0, 0); if ((nb & 3) == 3) __builtin_amdgcn_sched_barrier(0); } }
#pragma unroll 1
    for (int dir = 0; dir < 2; ++dir) {
        __syncthreads();
        const bf16_t* Sg = KVS + ((size_t)(bh * NSLOT + c + 2) * 2 + dir) * 32768;
#pragma unroll
        for (int it = 0; it < 8; ++it) { const int p = tid + it * 512, r = p >> 4, cc = p & 15; *(LAS u32x4*)(CS + r * 272 + cc * 16) = *(const u32x4*)(Sg + (size_t)r * 128 + cc * 8); }
        __syncthreads();
        const int ia = 16 * w + r16; const float sf = dir == 0 ? __builtin_amdgcn_exp2f(l2f * (float)(ia + 1)) : __builtin_amdgcn_exp2f(l2b * (float)(128 - ia));
#pragma unroll
        for (int ks = 0; ks < 4; ++ks) { bf16x8 qs; const bf16x8 q0 = *(const LAS bf16x8*)(QS + (16 * w + r16) * 272 + (32 * ks + 8 * g) * 2);
#pragma unroll
            for (int e = 0; e < 8; e += 2) { const unsigned pk = pk2(bf1(q0[e]) * sf, bf1(q0[e + 1]) * sf); qs[e] = (short)(pk & 0xffffu); qs[e + 1] = (short)(pk >> 16); }
#pragma unroll
            for (int nb = 0; nb < 16; ++nb) { const bf16x8 sfr = *(const LAS bf16x8*)(CS + (16 * nb + r16) * 272 + (32 * ks + 8 * g) * 2); acc[nb] = __builtin_amdgcn_mfma_f32_16x16x32_bf16(qs, sfr, acc[nb], 0, 0, 0); if ((nb & 3) == 3) __builtin_amdgcn_sched_barrier(0); } }
    }
#pragma unroll
    for (int jj = 0; jj < 4; ++jj) {
        float s = 0.f;
#pragma unroll
        for (int nb = 0; nb < 16; ++nb) s += acc[nb][jj];
        s += __shfl_xor(s, 1); s += __shfl_xor(s, 2); s += __shfl_xor(s, 4); s += __shfl_xor(s, 8);
        const float mu = s * (1.0f / 256.0f); float q = 0.f;
#pragma unroll
        for (int nb = 0; nb < 16; ++nb) { const float d = acc[nb][jj] - mu; q += d * d; }
        q += __shfl_xor(q, 1); q += __shfl_xor(q, 2); q += __shfl_xor(q, 4); q += __shfl_xor(q, 8);
        const float rstd = 1.0f / sqrtf(q * (1.0f / 256.0f) + 1e-5f);
        const size_t ro = (size_t)(row0 + 16 * w + 4 * g + jj) * DM + h * 256 + r16;
#pragma unroll
        for (int nb = 0; nb < 16; ++nb) { const float gs = __builtin_bit_cast(float, ((unsigned)Gs[ro + 16 * nb]) << 16); ZA[ro + 16 * nb] = (bf16_t)f2bf(gs * (acc[nb][jj] - mu) * rstd); }
    }
    __syncthreads();
}

__global__ void __launch_bounds__(512, 2) fwd_megakernel(Args args) {
    extern __shared__ __attribute__((aligned(16))) unsigned char lds_raw[];
    LAS unsigned char* lds = (LAS unsigned char*)lds_raw;
    cg::grid_group grid = cg::this_grid();
    const int tid = threadIdx.x, lane = tid & 63, wave = __builtin_amdgcn_readfirstlane(tid >> 6);
    const int G = gridDim.x, bx = blockIdx.x;
    const int gw = bx * 8 + wave, NGW = G * 8;
    unsigned char* ws = args.ws;
    const float* x = args.in[0]; const float* cvec = args.in[1]; const float* ctx = args.in[2]; const float* cctx = args.in[3];
    const float* w_ada = args.in[4]; const float* b_ada = args.in[5]; const float* norm_g = args.in[6];
    const float* decay_logit = args.in[12]; const float* pool_scale = args.in[14]; const float* b_gate = args.in[18]; const float* final_g = args.in[20];
    float* out = args.out;
    float* MOD = (float*)(ws + WS_MOD); float* ROPE = (float*)(ws + WS_ROPE);
    bf16_t* W13A = (bf16_t*)(ws + WS_W13A); bf16_t* W2A = (bf16_t*)(ws + WS_W2A); bf16_t* W13B = (bf16_t*)(ws + WS_W13B); bf16_t* W2B = (bf16_t*)(ws + WS_W2B);
    bf16_t* WIN = (bf16_t*)(ws + WS_WIN); bf16_t* WOA = (bf16_t*)(ws + WS_WOA); bf16_t* WOB = (bf16_t*)(ws + WS_WOB); bf16_t* WOUT = (bf16_t*)(ws + WS_WOUT); bf16_t* POOLW = (bf16_t*)(ws + WS_POOLW);
    bf16_t* AN = (bf16_t*)(ws + WS_AN); bf16_t* H = (bf16_t*)(ws + WS_H); float* HC1 = (float*)(ws + WS_HC1);
    bf16_t* Kb = (bf16_t*)(ws + WS_K); bf16_t* Qb = (bf16_t*)(ws + WS_Q); bf16_t* Vb = (bf16_t*)(ws + WS_V); bf16_t* Gb = (bf16_t*)(ws + WS_G); bf16_t* PIN = (bf16_t*)(ws + WS_PIN);
    bf16_t* GA = (bf16_t*)(ws + WS_GA); bf16_t* GB = (bf16_t*)(ws + WS_GB); bf16_t* POOLED = (bf16_t*)(ws + WS_POOLED); bf16_t* PM = (bf16_t*)(ws + WS_PM);
    bf16_t* KVS = H; float* T1 = (float*)H; bf16_t* ZA = AN; bf16_t* MMb = Gb;

#ifdef PROBE_A
    unsigned long long t_probe0 = 0, t_probe1 = 0;
#define PSTAMP(k, var) do { if ((k) == PROBE_A) var = __builtin_amdgcn_s_memrealtime(); } while (0)
#define PSTAMP2(k, var) do { if ((k) == PROBE_B) var = __builtin_amdgcn_s_memrealtime(); } while (0)
#else
#define PSTAMP(k, var) do {} while (0)
#define PSTAMP2(k, var) do {} while (0)
#endif
    volatile LAS unsigned* xst = (volatile LAS unsigned*)(lds + LDS_BYTES - 64);
    if (tid < 2) xst[tid] = 0u;
    __syncthreads();
    const XcdBarrier xbar = xcd_barrier_post((unsigned*)(ws + WS_BAR), xst);
    if (args.pad0 == 0x5a5a5a5a) grid.sync();
    PSTAMP(0, t_probe0); PSTAMP2(0, t_probe1);
    {
        LAS float* scr = (LAS float*)(lds + wave * 16640);
        constexpr int I_13 = 32 * 176, I_2 = 88 * 32, I_IN = 32 * 112, I_GT = 32 * 64, I_OA = 32 * 32, I_OB = 16 * 32, I_OUT = 32 * 32, I_PW = 16;
        constexpr int NIT = 2 * I_13 + 2 * I_2 + I_IN + I_GT + I_OA + I_OB + I_OUT + 4 * I_PW;
        for (int it = gw; it < NIT; it += NGW) {
            int r = it;
            if (r < I_13) { tr_item(args.in[7], DM, 2 * DFF, W13A, 0, 1, scr, r, lane); continue; } r -= I_13;
            if (r < I_13) { tr_item(args.in[9], DM, 2 * DFF, W13B, 0, 1, scr, r, lane); continue; } r -= I_13;
            if (r < I_2) { tr_item(args.in[8], DFF, DM, W2A, 0, 0, scr, r, lane); continue; } r -= I_2;
            if (r < I_2) { tr_item(args.in[10], DFF, DM, W2B, 0, 0, scr, r, lane); continue; } r -= I_2;
            if (r < I_IN) { tr_item(args.in[11], DM, 7168, WIN, 0, 2, scr, r, lane); continue; } r -= I_IN;
            if (r < I_GT) { tr_item(args.in[17], DM, 4096, WIN, 7168, 0, scr, r, lane); continue; } r -= I_GT;
            if (r < I_OA) { tr_item(args.in[15], DM, DM, WOA, 0, 0, scr, r, lane); continue; } r -= I_OA;
            if (r < I_OB) { tr_item(args.in[16], 1024, DM, WOB, 0, 0, scr, r, lane); continue; } r -= I_OB;
            if (r < I_OUT) { tr_item(args.in[19], DM, DM, WOUT, 0, 0, scr, r, lane); continue; } r -= I_OUT;
            { const int gp = r >> 4; tr_item(args.in[13] + (size_t)gp * 65536, 256, 256, POOLW + (size_t)gp * 65536, 0, 0, scr, r & 15, lane); }
        }
        for (int it = gw; it < 72 * 32; it += NGW) {
            const int cgp = it % 72, kc = it / 72, col = cgp * 256 + lane * 4, k = kc * 64 + lane;
            const float s0 = fsilu(cvec[k]), s1 = fsilu(cvec[DM + k]), s2 = fsilu(cctx[k]);
            f32x4 a0 = {0.f, 0.f, 0.f, 0.f}, a1 = a0, a2 = a0;
#pragma unroll 16
            for (int kk = 0; kk < 64; ++kk) { const f32x4 wv = *(const f32x4*)(w_ada + (size_t)(kc * 64 + kk) * NMOD + col);
                a0 += wv * __shfl(s0, kk); a1 += wv * __shfl(s1, kk); a2 += wv * __shfl(s2, kk); }
            if (kc == 0) { const f32x4 bv = *(const f32x4*)(b_ada + col); a0 += bv; a1 += bv; a2 += bv; }
#pragma unroll
            for (int e = 0; e < 4; ++e) { __hip_atomic_fetch_add(MOD + col + e, a0[e], __ATOMIC_RELAXED, __HIP_MEMORY_SCOPE_AGENT); __hip_atomic_fetch_add(MOD + NMOD + col + e, a1[e], __ATOMIC_RELAXED, __HIP_MEMORY_SCOPE_AGENT);
                __hip_atomic_fetch_add(MOD + 2 * NMOD + col + e, a2[e], __ATOMIC_RELAXED, __HIP_MEMORY_SCOPE_AGENT); }
        }
        { const int id = bx * 512 + tid; if (id < 2048) { const int pos = id >> 5, i = id & 31; const float inv = powf(10000.0f, -(float)i * (1.0f / 32.0f)); const float ang = (float)pos * inv; ROPE[2 * id] = cosf(ang); ROPE[2 * id + 1] = sinf(ang); } }
    }
    GRID_SYNC();
#if defined(STOP) && STOP == 100
    for (size_t i = (size_t)bx * 512 + tid; i < (size_t)NLAT * DM; i += (size_t)G * 512) out[i] = bf1((short)WIN[i]) + (i + (size_t)NLAT * DM < (size_t)11264 * 2048 ? bf1((short)WIN[i + (size_t)NLAT * DM]) : 0.f);
    return;
#endif
    PSTAMP(1, t_probe0); PSTAMP2(1, t_probe1);
    norm_rows(x, ctx, MT, norm_g, MOD, 0, 1, AN, gw, NGW, lane);
    for (int i = bx * 512 + tid; i < NCTX * DM / 4; i += G * 512) ((f32x4*)HC1)[i] = ((const f32x4*)ctx)[i];
    GRID_SYNC();
    PSTAMP(2, t_probe0); PSTAMP2(2, t_probe1);
    { pg8::Gemm g{AN, W13A, DM, DM}; pg8::MixOrder S; S.init(32, 44, 2, 44, G, bx, 32); pg8::EpiSwiglu E{H, DFF}; pg8::gemm_phase<pg8::EpiSwiglu, pg8::MixOrder, true>(lds, g, S, E); }
    GRID_SYNC();
    PSTAMP(3, t_probe0); PSTAMP2(3, t_probe1);
    { pg8::Gemm g{H, W2A, DFF, DFF}; pg8::MixOrder S; S.init(32, 8, 2, 8, G, bx, 88, 11); pg8::EpiResid E{x, out, HC1, MOD, 2, 0.5f}; pg8::gemm_phase<pg8::EpiResid, pg8::MixOrder, true>(lds, g, S, E); }
    GRID_SYNC();
#if defined(STOP) && STOP == 3
    return;
#endif
    PSTAMP(4, t_probe0); PSTAMP2(4, t_probe1);
    norm_rows(out, HC1, MT, norm_g + DM, MOD, 3, 4, AN, gw, NGW, lane);
    GRID_SYNC();
#if defined(STOP) && STOP == 4
    for (size_t i = (size_t)bx * 512 + tid; i < (size_t)NLAT * DM; i += (size_t)G * 512) out[i] = bf1((short)AN[i]) + ((i >> 11) < 512 ? bf1((short)AN[i + (size_t)NLAT * DM]) : 0.f);
    return;
#endif
    PSTAMP(5, t_probe0); PSTAMP2(5, t_probe1);
    { pg8::Gemm g{AN, WIN, DM, DM}; pg8::MixOrder S; S.init(32, 44, 2, 12, G, bx, 32); pg8::EpiIn E{Kb, Qb, Vb, Gb, PIN, GA, GB, b_gate, ROPE}; pg8::gemm_phase<pg8::EpiIn, pg8::MixOrder, true>(lds, g, S, E); }
    GRID_SYNC();
#if defined(STOP) && STOP == 5
    for (size_t i = (size_t)bx * 512 + tid; i < (size_t)NLAT * DM; i += (size_t)G * 512) { const size_t r = i >> 11, c = i & 2047; out[i] = bf1((short)Kb[r * 1024 + (c & 1023)]) + bf1((short)Qb[r * 1024 + (c & 1023)]) + bf1((short)Vb[i]) + bf1((short)Gb[i]) + bf1((short)PIN[r * 1024 + (c & 1023)]) + bf1((short)GA[i]) + bf1((short)GB[i]); }
    return;
#endif
    PSTAMP(6, t_probe0); PSTAMP2(6, t_probe1);
    for (int t = bx; t < 16 * NSLOT; t += G) r1_task(lds, t, Kb, Vb, KVS, decay_logit);
    for (int it = bx * 512 + tid; it < NLAT * 128; it += G * 512) {
        const int r = it >> 7, pc = it & 127, gp = pc >> 5, win = 2 << gp, lo = win >> 1, hi = win - 1 - lo, t = r & (SEQ - 1), rb = r - t;
        const int st = t - lo < 0 ? 0 : t - lo, en = t + hi + 1 > SEQ ? SEQ : t + hi + 1;
        float s[8] = {0.f, 0.f, 0.f, 0.f, 0.f, 0.f, 0.f, 0.f};
        for (int q = st; q < en; ++q) { const u32x4 v = *(const u32x4*)(PIN + (size_t)(rb + q) * 1024 + pc * 8);
            s[0] += bflo(v.x); s[1] += bfhi(v.x); s[2] += bflo(v.y); s[3] += bfhi(v.y); s[4] += bflo(v.z); s[5] += bfhi(v.z); s[6] += bflo(v.w); s[7] += bfhi(v.w); }
        const float ic = 1.0f / (float)(en - st); const u32x4 v = *(const u32x4*)(PIN + (size_t)r * 1024 + pc * 8);
        u32x4 o; o.x = pk2(s[0] * ic - bflo(v.x), s[1] * ic - bfhi(v.x)); o.y = pk2(s[2] * ic - bflo(v.y), s[3] * ic - bfhi(v.y)); o.z = pk2(s[4] * ic - bflo(v.z), s[5] * ic - bfhi(v.z)); o.w = pk2(s[6] * ic - bflo(v.w), s[7] * ic - bfhi(v.w));
        *(u32x4*)(POOLED + (size_t)r * 1024 + pc * 8) = o;
    }
    GRID_SYNC();
    PSTAMP(7, t_probe0); PSTAMP2(7, t_probe1);
    for (int id = bx * 512 + tid; id < 16 * 2 * 4096; id += G * 512) {
        const int bh = id >> 13, dir = (id >> 12) & 1, off = (id & 4095) * 8, h = bh & 7;
        const float cd = __builtin_amdgcn_exp2f(log2_gamma(decay_logit, dir, h) * 128.0f);
        bf16_t* base = KVS + (size_t)bh * NSLOT * 65536 + dir * 32768 + off;
        float r[8] = {0.f, 0.f, 0.f, 0.f, 0.f, 0.f, 0.f, 0.f};
#pragma unroll 2
        for (int s = 0; s < NSLOT; ++s) {
            const int slot = dir == 0 ? s : (s == 0 ? 1 : (s == 1 ? 0 : NSLOT + 1 - s));
            u32x4* p = (u32x4*)(base + (size_t)slot * 65536); const u32x4 v = *p;
            u32x4 o; o.x = pk2(r[0], r[1]); o.y = pk2(r[2], r[3]); o.z = pk2(r[4], r[5]); o.w = pk2(r[6], r[7]); *p = o;
            r[0] = r[0] * cd + bflo(v.x); r[1] = r[1] * cd + bfhi(v.x); r[2] = r[2] * cd + bflo(v.y); r[3] = r[3] * cd + bfhi(v.y);
            r[4] = r[4] * cd + bflo(v.z); r[5] = r[5] * cd + bfhi(v.z); r[6] = r[6] * cd + bflo(v.w); r[7] = r[7] * cd + bfhi(v.w);
        }
    }
    { const int gp = (bx >> 5) & 3; pg8::Gemm g{POOLED + gp * 256, POOLW + (size_t)gp * 65536, 1024, 256}; pg8::MixOrder S; S.init(32, 1, 0, 1, 1 << 20, bx < 128 ? (bx & 31) : 32, 4);
        pg8::EpiPool E{PM, pool_scale, gp}; pg8::gemm_phase<pg8::EpiPool, pg8::MixOrder, true>(lds, g, S, E); }
    GRID_SYNC();
#if defined(STOP) && STOP == 7
    for (size_t i = (size_t)bx * 512 + tid; i < (size_t)NLAT * DM; i += (size_t)G * 512) { const size_t r = i >> 11, c = i & 2047; out[i] = bf1((short)POOLED[r * 1024 + (c & 1023)]) + bf1((short)PM[r * 1024 + (c & 1023)]) + bf1((short)KVS[i]) + bf1((short)KVS[i + (size_t)NLAT * DM]); }
    return;
#endif
    PSTAMP(8, t_probe0); PSTAMP2(8, t_probe1);
    for (int t = bx; t < 512; t += G) r3_task(lds, t, Qb, Kb, Vb, KVS, Gb, ZA, decay_logit);
    GRID_SYNC();
#if defined(STOP) && STOP == 8
    for (size_t i = (size_t)bx * 512 + tid; i < (size_t)NLAT * DM; i += (size_t)G * 512) out[i] = bf1((short)ZA[i]);
    return;
#endif
    PSTAMP(9, t_probe0); PSTAMP2(9, t_probe1);
    { pg8::Gemm g{ZA, WOA, DM, DM}; pg8::MixOrder S; S.init(32, 8, 0, 1, G, bx, 32); pg8::EpiMergeA E{T1, GA}; pg8::gemm_phase<pg8::EpiMergeA, pg8::MixOrder, true>(lds, g, S, E); }
    { pg8::Gemm g{PM, WOB, 1024, 1024}; pg8::MixOrder S; S.init(32, 8, 0, 1, G, bx, 16); pg8::EpiMergeB E{T1, GB, MMb}; pg8::gemm_phase<pg8::EpiMergeB, pg8::MixOrder, true>(lds, g, S, E); }
    GRID_SYNC();
#if defined(STOP) && STOP == 9
    for (size_t i = (size_t)bx * 512 + tid; i < (size_t)NLAT * DM; i += (size_t)G * 512) out[i] = bf1((short)MMb[i]);
    return;
#endif
    PSTAMP(10, t_probe0); PSTAMP2(10, t_probe1);
    { pg8::Gemm g{MMb, WOUT, DM, DM}; pg8::MixOrder S; S.init(32, 8, 0, 1, G, bx, 32); pg8::EpiResid E{out, out, out, MOD, 5, 1.0f}; pg8::gemm_phase<pg8::EpiResid, pg8::MixOrder, true>(lds, g, S, E); }
    GRID_SYNC();
    PSTAMP(11, t_probe0); PSTAMP2(11, t_probe1);
    norm_rows(out, out, NLAT, norm_g + 2 * DM, MOD, 6, 7, AN, gw, NGW, lane);
    GRID_SYNC();
    PSTAMP(12, t_probe0); PSTAMP2(12, t_probe1);
    { pg8::Gemm g{AN, W13B, DM, DM}; pg8::MixOrder S; S.init(32, 44, 0, 1, G, bx, 32); pg8::EpiSwiglu E{H, DFF}; pg8::gemm_phase<pg8::EpiSwiglu, pg8::MixOrder, true>(lds, g, S, E); }
    GRID_SYNC();
    PSTAMP(13, t_probe0); PSTAMP2(13, t_probe1);
    { pg8::Gemm g{H, W2B, DFF, DFF}; pg8::MixOrder S; S.init(32, 8, 0, 1, G, bx, 88); pg8::EpiResid E{out, out, out, MOD, 8, 0.5f}; pg8::gemm_phase<pg8::EpiResid, pg8::MixOrder, true>(lds, g, S, E); }
    GRID_SYNC();
    PSTAMP(14, t_probe0); PSTAMP2(14, t_probe1);
    for (int r = gw; r < NLAT; r += NGW) {
        f32x4* s4 = (f32x4*)(out + (size_t)r * DM) + lane;
        f32x4 v[8]; float ss = 0.f;
#pragma unroll
        for (int j = 0; j < 8; ++j) { v[j] = s4[64 * j]; ss += (v[j][0] * v[j][0] + v[j][1] * v[j][1]) + (v[j][2] * v[j][2] + v[j][3] * v[j][3]); }
        const float rstd = 1.0f / sqrtf(wave_sum(ss) * (1.0f / DM) + 1e-6f);
        const f32x4* g4 = (const f32x4*)final_g + lane;
#pragma unroll
        for (int j = 0; j < 8; ++j) s4[64 * j] = v[j] * rstd * g4[64 * j];
    }
#ifdef PROBE_A
    PSTAMP2(15, t_probe1);
    GRID_SYNC();
    if (bx == 0) { const unsigned long long dt = __shfl(t_probe1 - t_probe0, 0); const int n = (int)(dt / PDIV); for (int i = tid; i < n && i < 14000; i += 512) out[(size_t)i * 97 + 5] += 0.15f; }
#endif
}

extern "C" void kernel_launch(void* const* d_in, const int* in_sizes, int n_in, void* d_out, int out_size, void* d_ws, size_t ws_size, hipStream_t stream) {
    static int grid = 0;
    if (grid == 0) {
        if (n_in != 21 || out_size != NLAT * DM || ws_size < WS_END) { fprintf(stderr, "kernel_launch: unexpected shapes (n_in %d out %d ws %zu need %zu)\n", n_in, out_size, ws_size, (size_t)WS_END); grid = -1; return; }
        int dev = 0, cus = 0, per_cu = 0;
        (void)hipGetDevice(&dev);
        (void)hipDeviceGetAttribute(&cus, hipDeviceAttributeMultiprocessorCount, dev);
        (void)hipFuncSetAttribute((const void*)fwd_megakernel, hipFuncAttributeMaxDynamicSharedMemorySize, LDS_BYTES);
        (void)hipOccupancyMaxActiveBlocksPerMultiprocessor(&per_cu, (const void*)fwd_megakernel, 512, LDS_BYTES);
        (void)hipGetLastError();
        if (per_cu < 1) fprintf(stderr, "kernel_launch: occupancy query says %d blocks per CU\n", per_cu);
        grid = cus;
    }
    if (grid < 0) return;
    (void)hipMemsetAsync((char*)d_ws, 0, 512 * 1024, stream);
    Args a{};
    for (int i = 0; i < 21; ++i) a.in[i] = (const float*)d_in[i];
    a.out = (float*)d_out; a.ws = (unsigned char*)d_ws;
    void* kargs[] = {&a};
    hipError_t e = hipLaunchCooperativeKernel((const void*)fwd_megakernel, dim3(grid), dim3(512), kargs, LDS_BYTES, stream);
    if (e != hipSuccess) fprintf(stderr, "cooperative launch failed: %s (grid %d)\n", hipGetErrorString(e), grid);
}
```

```cpp
#include <hip/hip_runtime.h>
#include <hip/hip_cooperative_groups.h>
#include <cstdio>
#include <cstdint>
namespace cg = cooperative_groups;

#define LAS __attribute__((address_space(3)))
typedef unsigned short bf16_t;
typedef short bf16x8 __attribute__((ext_vector_type(8)));
typedef short s16x4 __attribute__((ext_vector_type(4)));
typedef float f32x4 __attribute__((ext_vector_type(4)));
typedef unsigned u32x4 __attribute__((ext_vector_type(4)));
typedef unsigned u32x2 __attribute__((ext_vector_type(2)));

constexpr int DM = 2048, SEQ = 4096, NLAT = 8192, NCTX = 512, MT = NLAT + NCTX, CTXL = 256;
constexpr int DFF = 5632, NMOD = 9 * DM;
constexpr int NSLOT = 34;
constexpr float LOG2E = 1.4426950408889634f;

constexpr size_t MiB = 1u << 20;
constexpr size_t WS_MOD = 0;
constexpr size_t WS_BAR = 256 * 1024;
constexpr size_t WS_ROPE = 512 * 1024;
constexpr size_t WS_W13A = 1 * MiB, WS_W2A = 45 * MiB, WS_W13B = 67 * MiB, WS_W2B = 111 * MiB, WS_WIN = 133 * MiB;
constexpr size_t WS_WOA = 177 * MiB, WS_WOB = 185 * MiB, WS_WOUT = 189 * MiB, WS_POOLW = 197 * MiB;
constexpr size_t WS_AN = 198 * MiB;
constexpr size_t WS_H = 232 * MiB;
constexpr size_t WS_HC1 = 326 * MiB;
constexpr size_t WS_K = 330 * MiB, WS_Q = 347 * MiB, WS_V = 363 * MiB, WS_G = 397 * MiB, WS_PIN = 429 * MiB, WS_GA = 445 * MiB, WS_GB = 477 * MiB;
constexpr size_t WS_POOLED = 509 * MiB, WS_PM = 525 * MiB, WS_END = 541 * MiB;
constexpr int LDS_BYTES = 147456;

__device__ __forceinline__ unsigned f2bf(float f) { unsigned u = __builtin_bit_cast(unsigned, f); return (u + 0x7fffu + ((u >> 16) & 1u)) >> 16; }
typedef float f32x2_t __attribute__((ext_vector_type(2))); typedef __bf16 bf16x2_t __attribute__((ext_vector_type(2)));
__device__ __forceinline__ unsigned pk2(float lo, float hi) { f32x2_t v = {lo, hi}; bf16x2_t b = __builtin_convertvector(v, bf16x2_t); return __builtin_bit_cast(unsigned, b); }
__device__ __forceinline__ float bflo(unsigned w) { return __builtin_bit_cast(float, w << 16); }
__device__ __forceinline__ float bfhi(unsigned w) { return __builtin_bit_cast(float, w & 0xffff0000u); }
__device__ __forceinline__ float bf1(short s) { return __builtin_bit_cast(float, ((unsigned)(unsigned short)s) << 16); }
__device__ __forceinline__ float fsilu(float a) { return a * __builtin_amdgcn_rcpf(1.0f + __builtin_amdgcn_exp2f(-a * LOG2E)); }
__device__ __forceinline__ float fsigm(float a) { return __builtin_amdgcn_rcpf(1.0f + __builtin_amdgcn_exp2f(-a * LOG2E)); }
__device__ __forceinline__ float wave_sum(float v) {
#pragma unroll
    for (int o = 1; o < 64; o <<= 1) v += __shfl_xor(v, o);
    return v;
}

namespace pg8 {
constexpr int BM = 256, BK = 64, HALF = 128, HTB = HALF * BK * 2, STAGE_BYTES = 8 * HTB, NXCD = 8, WGM = 8;
__device__ __forceinline__ int lds_byte(int r, int c) { const int st = (r >> 4) * 2 + (c >> 5), rr = r & 15, cc = c & 31, ob = rr * 64 + cc * 2; return st * 1024 + (ob ^ (((ob >> 9) & 1) << 5)); }
__device__ __forceinline__ void stage_rc(int b, int& R, int& C) { const int st = b / 1024, sb = b % 1024, swz = sb ^ (((sb >> 9) & 1) << 5); R = (st >> 1) * 16 + swz / 64; C = (st & 1) * 32 + (swz % 64) / 2; }
__device__ __forceinline__ int perm32(int rho) { const int n = rho >> 4, i = rho & 15; return 8 * (i >> 2) + 4 * n + (i & 3); }
struct Unit { int pm, pn, k0, nt; };
struct Gemm { const bf16_t* A; const bf16_t* Bt; int lda, ldb; };

struct MixOrder {
    int nMl, nN, nLat, nNc, nCtx, G, c, ntf, nsp, ntp;
    __device__ void init(int nMl_, int nN_, int nMc_, int nNc_, int G_, int c_, int ntf_, int nsp_ = 1) { nMl = nMl_; nN = nN_; nLat = nMl_ * nN_; nNc = nNc_; nsp = nsp_; nCtx = nMc_ * nNc_ * nsp_; G = G_; c = c_; ntf = ntf_; ntp = ntf_ / nsp_; }
    __device__ bool next(int i, Unit& u) const {
        long L = (long)i * G + c;
        if (L < nLat) {
            const int nwg = nLat, nM = nMl;
            int wgid = (int)L; { const int q = nwg / NXCD, r = nwg % NXCD, xcd = wgid % NXCD, off = wgid / NXCD; wgid = (xcd < r ? xcd * (q + 1) : r * (q + 1) + (xcd - r) * q) + off; }
            const int nig = WGM * nN, gid = wgid / nig, fm = gid * WGM, gsz = (nM - fm) < WGM ? (nM - fm) : WGM;
            u.pm = fm + ((wgid % nig) % gsz); u.pn = (wgid % nig) / gsz; u.k0 = 0; u.nt = ntf; return true;
        }
        L -= nLat;
        if (L < nCtx) { const int t = (int)(L / nsp), p = (int)(L % nsp); u.pm = nMl + t / nNc; u.pn = t % nNc; u.k0 = p * ntp; u.nt = ntp; return true; }
        return false;
    }
};

__device__ __forceinline__ unsigned cvt_pk_bf16(float lo, float hi) { return pk2(lo, hi); }
__device__ __forceinline__ u32x4 pack8(const f32x4 a, const f32x4 b) { u32x4 w; w.x = cvt_pk_bf16(a[0], a[1]); w.y = cvt_pk_bf16(a[2], a[3]); w.z = cvt_pk_bf16(b[0], b[1]); w.w = cvt_pk_bf16(b[2], b[3]); return w; }

struct EpiSwiglu {
    static constexpr bool PERM = true;
    bf16_t* O; int ldc;
    __device__ __forceinline__ void operator()(const f32x4 (&acc)[2][2][4][2], const Unit& u, int wr, int wc, int fr, int fq) const {
        const int row0 = u.pm * BM + wr * 64 + fr, col0 = u.pn * HALF + wc * 32 + 8 * fq;
#pragma unroll
        for (int ai = 0; ai < 2; ++ai)
#pragma unroll
            for (int m = 0; m < 4; ++m) {
                f32x4 h0, h1;
#pragma unroll
                for (int e = 0; e < 4; ++e) { h0[e] = fsilu(acc[ai][0][m][0][e]) * acc[ai][1][m][0][e]; h1[e] = fsilu(acc[ai][0][m][1][e]) * acc[ai][1][m][1][e]; }
                *(u32x4*)(O + (size_t)(row0 + ai * HALF + m * 16) * ldc + col0) = pack8(h0, h1);
            }
    }
};
struct EpiResid {
    static constexpr bool PERM = false;
    const float* res_lat; float* out_lat; float* out_ctx; const float* mod; int gidx; float scale;
    __device__ __forceinline__ void operator()(const f32x4 (&acc)[2][2][4][2], const Unit& u, int wr, int wc, int fr, int fq) const {
        const bool ctx = u.pm >= 32; const int bsel = ctx ? 2 : (u.pm >= 16 ? 1 : 0);
        const int row0 = (ctx ? (u.pm - 32) : u.pm) * BM + wr * 64 + fr, col0 = u.pn * BM + wc * 32 + 4 * fq;
        const float* gate = mod + bsel * NMOD + gidx * DM;
        f32x4 gv[2][2];
#pragma unroll
        for (int bj = 0; bj < 2; ++bj)
#pragma unroll
            for (int n = 0; n < 2; ++n) gv[bj][n] = *(const f32x4*)(gate + col0 + bj * HALF + n * 16) * scale;
        if (!ctx) {
#pragma unroll
            for (int ai = 0; ai < 2; ++ai)
#pragma unroll
                for (int m = 0; m < 4; ++m) { const size_t off = (size_t)(row0 + ai * HALF + m * 16) * DM + col0;
#pragma unroll
                    for (int bj = 0; bj < 2; ++bj)
#pragma unroll
                        for (int n = 0; n < 2; ++n) { const size_t o = off + bj * HALF + n * 16; const f32x4 r = *(const f32x4*)(res_lat + o); *(f32x4*)(out_lat + o) = r + gv[bj][n] * acc[ai][bj][m][n]; } }
        } else {
#pragma unroll
            for (int ai = 0; ai < 2; ++ai)
#pragma unroll
                for (int m = 0; m < 4; ++m) { const size_t off = (size_t)(row0 + ai * HALF + m * 16) * DM + col0;
#pragma unroll
                    for (int bj = 0; bj < 2; ++bj)
#pragma unroll
                        for (int n = 0; n < 2; ++n) *(f32x4*)(out_ctx + (size_t)(u.k0 / u.nt) * (NCTX * DM) + off + bj * HALF + n * 16) = gv[bj][n] * acc[ai][bj][m][n]; }
        }
    }
};
struct EpiIn {
    static constexpr bool PERM = true;
    bf16_t *K, *Q, *V, *G, *PIN, *GA, *GB; const float* bgate; const float* rope;
    __device__ __forceinline__ void operator()(const f32x4 (&acc)[2][2][4][2], const Unit& u, int wr, int wc, int fr, int fq) const {
        const int row0 = u.pm * BM + wr * 64 + fr, cb = wc * 32 + 8 * fq, pn = u.pn;
        if (pn < 4 || (pn >= 12 && pn < 16)) {
            const bool isk = pn < 4; bf16_t* dst = isk ? K : Q; const int hcol = (isk ? pn : pn - 12) * BM; const float sc = isk ? 0.08838834764831845f : 1.0f;
            const bool lat = u.pm < 32; const int i0 = (16 * wc + 4 * fq) & 31;
#pragma unroll
            for (int ai = 0; ai < 2; ++ai)
#pragma unroll
                for (int m = 0; m < 4; ++m) {
                    const int row = row0 + ai * HALF + m * 16;
                    f32x4 cs0 = {1.f, 0.f, 1.f, 0.f}, cs1 = {1.f, 0.f, 1.f, 0.f};
                    if (lat) { const int t = row & 4095; const int pos = (wc < 2) ? (t >> 6) : (t & 63); const float* rp = rope + (pos * 32 + i0) * 2; cs0 = *(const f32x4*)rp; cs1 = *(const f32x4*)(rp + 4); }
                    const float c_[4] = {cs0[0], cs0[2], cs1[0], cs1[2]}, s_[4] = {cs0[1], cs0[3], cs1[1], cs1[3]};
#pragma unroll
                    for (int bj = 0; bj < 2; ++bj) { const f32x4 x1 = acc[ai][bj][m][0], x2 = acc[ai][bj][m][1]; f32x4 o1, o2;
#pragma unroll
                        for (int e = 0; e < 4; ++e) { o1[e] = (x1[e] * c_[e] - x2[e] * s_[e]) * sc; o2[e] = (x1[e] * s_[e] + x2[e] * c_[e]) * sc; }
                        *(u32x4*)(dst + (size_t)row * 1024 + hcol + bj * HALF + cb) = pack8(o1, o2); }
                }
        } else if (pn < 12) {
#pragma unroll
            for (int ai = 0; ai < 2; ++ai)
#pragma unroll
                for (int m = 0; m < 4; ++m)
#pragma unroll
                    for (int bj = 0; bj < 2; ++bj) *(u32x4*)(V + (size_t)(row0 + ai * HALF + m * 16) * DM + (pn - 4) * BM + bj * HALF + cb) = pack8(acc[ai][bj][m][0], acc[ai][bj][m][1]);
        } else if (pn < 24) {
#pragma unroll
            for (int ai = 0; ai < 2; ++ai)
#pragma unroll
                for (int m = 0; m < 4; ++m)
#pragma unroll
                    for (int bj = 0; bj < 2; ++bj) { f32x4 a = acc[ai][bj][m][0], b = acc[ai][bj][m][1];
#pragma unroll
                        for (int e = 0; e < 4; ++e) { a[e] = fsilu(a[e]); b[e] = fsilu(b[e]); }
                        *(u32x4*)(G + (size_t)(row0 + ai * HALF + m * 16) * DM + (pn - 16) * BM + bj * HALF + cb) = pack8(a, b); }
        } else if (pn < 28) {
#pragma unroll
            for (int ai = 0; ai < 2; ++ai)
#pragma unroll
                for (int m = 0; m < 4; ++m)
#pragma unroll
                    for (int bj = 0; bj < 2; ++bj) *(u32x4*)(PIN + (size_t)(row0 + ai * HALF + m * 16) * 1024 + (pn - 24) * BM + bj * HALF + cb) = pack8(acc[ai][bj][m][0], acc[ai][bj][m][1]);
        } else {
            const int gc = (pn - 28) * BM; bf16_t* dst = gc < DM ? GA : GB; const int dc = gc < DM ? gc : gc - DM;
#pragma unroll
            for (int bj = 0; bj < 2; ++bj) { const f32x4 b0 = *(const f32x4*)(bgate + gc + bj * HALF + cb), b1 = *(const f32x4*)(bgate + gc + bj * HALF + cb + 4);
#pragma unroll
                for (int ai = 0; ai < 2; ++ai)
#pragma unroll
                    for (int m = 0; m < 4; ++m) { f32x4 a = acc[ai][bj][m][0] + b0, b = acc[ai][bj][m][1] + b1;
#pragma unroll
                        for (int e = 0; e < 4; ++e) { a[e] = fsigm(a[e]); b[e] = fsigm(b[e]); }
                        *(u32x4*)(dst + (size_t)(row0 + ai * HALF + m * 16) * DM + dc + bj * HALF + cb) = pack8(a, b); } }
        }
    }
};
struct EpiMergeA {
    static constexpr bool PERM = true;
    float* T1; const bf16_t* GA;
    __device__ __forceinline__ void operator()(const f32x4 (&acc)[2][2][4][2], const Unit& u, int wr, int wc, int fr, int fq) const {
        const int row0 = u.pm * BM + wr * 64 + fr, col0 = u.pn * BM + wc * 32 + 8 * fq;
#pragma unroll
        for (int ai = 0; ai < 2; ++ai)
#pragma unroll
            for (int m = 0; m < 4; ++m)
#pragma unroll
                for (int bj = 0; bj < 2; ++bj) { const size_t o = (size_t)(row0 + ai * HALF + m * 16) * DM + col0 + bj * HALF; const u32x4 g = *(const u32x4*)(GA + o);
                    const f32x4 g0 = {bflo(g.x), bfhi(g.x), bflo(g.y), bfhi(g.y)}, g1 = {bflo(g.z), bfhi(g.z), bflo(g.w), bfhi(g.w)};
                    *(f32x4*)(T1 + o) = g0 * acc[ai][bj][m][0]; *(f32x4*)(T1 + o + 4) = g1 * acc[ai][bj][m][1]; }
    }
};
struct EpiMergeB {
    static constexpr bool PERM = true;
    const float* T1; const bf16_t* GB; bf16_t* MM;
    __device__ __forceinline__ void operator()(const f32x4 (&acc)[2][2][4][2], const Unit& u, int wr, int wc, int fr, int fq) const {
        const int row0 = u.pm * BM + wr * 64 + fr, col0 = u.pn * BM + wc * 32 + 8 * fq;
#pragma unroll
        for (int ai = 0; ai < 2; ++ai)
#pragma unroll
            for (int m = 0; m < 4; ++m)
#pragma unroll
                for (int bj = 0; bj < 2; ++bj) { const size_t o = (size_t)(row0 + ai * HALF + m * 16) * DM + col0 + bj * HALF; const u32x4 g = *(const u32x4*)(GB + o);
                    const f32x4 g0 = {bflo(g.x), bfhi(g.x), bflo(g.y), bfhi(g.y)}, g1 = {bflo(g.z), bfhi(g.z), bflo(g.w), bfhi(g.w)};
                    const f32x4 t0 = *(const f32x4*)(T1 + o), t1 = *(const f32x4*)(T1 + o + 4);
                    *(u32x4*)(MM + o) = pack8(t0 + g0 * acc[ai][bj][m][0], t1 + g1 * acc[ai][bj][m][1]); }
    }
};
struct EpiPool {
    static constexpr bool PERM = true;
    bf16_t* PM; const float* pscale; int g;
    __device__ __forceinline__ void operator()(const f32x4 (&acc)[2][2][4][2], const Unit& u, int wr, int wc, int fr, int fq) const {
        const int row0 = u.pm * BM + wr * 64 + fr, col0 = g * BM + wc * 32 + 8 * fq;
#pragma unroll
        for (int bj = 0; bj < 2; ++bj) { const f32x4 s0 = *(const f32x4*)(pscale + col0 + bj * HALF), s1 = *(const f32x4*)(pscale + col0 + bj * HALF + 4);
#pragma unroll
            for (int ai = 0; ai < 2; ++ai)
#pragma unroll
                for (int m = 0; m < 4; ++m) *(u32x4*)(PM + (size_t)(row0 + ai * HALF + m * 16) * 1024 + col0 + bj * HALF) = pack8(acc[ai][bj][m][0] * s0, acc[ai][bj][m][1] * s1); }
    }
};

template <class Epi, class Sched, bool ALIGN_EPI>
__device__ __forceinline__ void gemm_phase(LAS unsigned char* lds, const Gemm g, const Sched& S, const Epi& E) {
    int tid = threadIdx.x; asm volatile("" : "+v"(tid));
    const int wid = __builtin_amdgcn_readfirstlane(tid >> 6), lane = tid & 63, wr = wid >> 2, wc = wid & 3, fr = lane & 15, fq = lane >> 4;
    unsigned voffA[2], voffB[2];
#pragma unroll
    for (int i = 0; i < 2; ++i) { int R, C; stage_rc(tid * 16 + i * 8192, R, C); const int Rb = Epi::PERM ? ((R & ~31) + perm32(R & 31)) : R;
        voffA[i] = (unsigned)(R * g.lda + C) * 2u; voffB[i] = (unsigned)(Rb * g.ldb + C) * 2u; }
    const size_t kstep = (size_t)(BK * 2);
    const size_t hstepA = (size_t)HALF * g.lda * 2, hstepB = (size_t)HALF * g.ldb * 2;
    const size_t tstepA = 2 * hstepA, tstepB = 2 * hstepB;
    const unsigned ldsw = (unsigned)wid * 1024u;
    const int aoff = lds_byte(wr * 64 + fr, fq * 8), boff = lds_byte(wc * 32 + fr, fq * 8);
#define PG8_SA(b, h) (((b) * 2 + (h)) * HTB)
#define PG8_SB(b, h) ((4 + (b) * 2 + (h)) * HTB)
#define PG8_STAGE(bufoff, gbase, voff) do { _Pragma("unroll") for (int _i = 0; _i < 2; ++_i) \
        __builtin_amdgcn_global_load_lds((const unsigned*)((const char*)(gbase) + (voff)[_i]), (LAS unsigned*)(lds + (bufoff) + ldsw + _i * 8192), 16, 0, 0); } while (0)
#define PG8_LDA(dst, b, h) do { _Pragma("unroll") for (int m = 0; m < 4; ++m) _Pragma("unroll") for (int k = 0; k < 2; ++k) dst[m][k] = *(const LAS bf16x8*)(lds + PG8_SA(b, h) + aoff + m * 2048 + k * 1024); } while (0)
#define PG8_LDB(dst, b, h) do { _Pragma("unroll") for (int n = 0; n < 2; ++n) _Pragma("unroll") for (int k = 0; k < 2; ++k) dst[n][k] = *(const LAS bf16x8*)(lds + PG8_SB(b, h) + boff + n * 2048 + k * 1024); } while (0)
#define PG8_MMA(ai, bj, At, Bt) do { __builtin_amdgcn_s_setprio(1); _Pragma("unroll") for (int m = 0; m < 4; ++m) _Pragma("unroll") for (int n = 0; n < 2; ++n) _Pragma("unroll") for (int k = 0; k < 2; ++k) \
        acc[ai][bj][m][n] = __builtin_amdgcn_mfma_f32_16x16x32_bf16(Bt[n][k], At[m][k], acc[ai][bj][m][n], 0, 0, 0); __builtin_amdgcn_s_setprio(0); } while (0)
#define PG8_WAIT_V(n) asm volatile("s_waitcnt vmcnt(" #n ")" ::: "memory")
#define PG8_WAIT_L(n) asm volatile("s_waitcnt lgkmcnt(" #n ")" ::: "memory")
#define PG8_BAR __builtin_amdgcn_s_barrier()
#define PG8_SCHED __builtin_amdgcn_sched_barrier(0)
    Unit cur, nxt; int ui = 0;
    if (!S.next(0, cur)) return;
    f32x4 acc[2][2][4][2];
#pragma unroll
    for (int a = 0; a < 2; ++a)
#pragma unroll
        for (int b = 0; b < 2; ++b)
#pragma unroll
            for (int m = 0; m < 4; ++m)
#pragma unroll
                for (int n = 0; n < 2; ++n) acc[a][b][m][n] = (f32x4){0.f, 0.f, 0.f, 0.f};
    bf16x8 At[4][2], B0[2][2], B1[2][2];
    const char* cA = (const char*)g.A + (size_t)cur.pm * tstepA + (size_t)cur.k0 * kstep; const char* cB = (const char*)g.Bt + (size_t)cur.pn * tstepB + (size_t)cur.k0 * kstep;
    PG8_STAGE(PG8_SB(0, 0), cB, voffB); PG8_STAGE(PG8_SB(0, 1), cB + hstepB, voffB); PG8_STAGE(PG8_SA(0, 0), cA, voffA); PG8_STAGE(PG8_SA(0, 1), cA + hstepA, voffA);
    if (wr == 1) PG8_BAR;
    PG8_WAIT_V(2); PG8_BAR;
    PG8_STAGE(PG8_SB(1, 0), cB + kstep, voffB); PG8_STAGE(PG8_SA(1, 0), cA + kstep, voffA); PG8_STAGE(PG8_SB(1, 1), cB + hstepB + kstep, voffB);
    PG8_WAIT_V(6); PG8_BAR;
    for (;;) {
        const bool has_next = S.next(ui + 1, nxt);
        const char* nA = has_next ? (const char*)g.A + (size_t)nxt.pm * tstepA + (size_t)nxt.k0 * kstep : cA; const char* nB = has_next ? (const char*)g.Bt + (size_t)nxt.pn * tstepB + (size_t)nxt.k0 * kstep : cB;
        const int nt = cur.nt;
#pragma unroll 1
        for (int t = 0; t < nt; t += 2) {
            const bool last = (t == nt - 2);
            const char* a1 = cA + (size_t)(t + 1) * kstep;
            const char* a2 = last ? nA : cA + (size_t)(t + 2) * kstep; const char* b2 = last ? nB : cB + (size_t)(t + 2) * kstep;
            const char* a3 = a2 + kstep; const char* b3 = b2 + kstep;
            PG8_LDB(B0, 0, 0); PG8_LDB(B1, 0, 1); PG8_SCHED; PG8_LDA(At, 0, 0); PG8_STAGE(PG8_SA(1, 1), a1 + hstepA, voffA);
            PG8_WAIT_V(8); PG8_WAIT_L(0); PG8_BAR; PG8_MMA(0, 0, At, B0); PG8_MMA(0, 1, At, B1); PG8_BAR; PG8_SCHED;
            PG8_LDA(At, 0, 1); PG8_STAGE(PG8_SB(0, 0), b2, voffB); PG8_STAGE(PG8_SB(0, 1), b2 + hstepB, voffB); PG8_STAGE(PG8_SA(0, 0), a2, voffA);
            PG8_WAIT_V(8); PG8_WAIT_L(0); PG8_BAR; PG8_MMA(1, 0, At, B0); PG8_MMA(1, 1, At, B1); PG8_BAR; PG8_SCHED;
            PG8_LDB(B0, 1, 0); PG8_LDB(B1, 1, 1); PG8_SCHED; PG8_LDA(At, 1, 0); PG8_STAGE(PG8_SA(0, 1), a2 + hstepA, voffA);
            PG8_WAIT_V(8); PG8_WAIT_L(0); PG8_BAR; PG8_MMA(0, 0, At, B0); PG8_MMA(0, 1, At, B1); PG8_BAR; PG8_SCHED;
            PG8_LDA(At, 1, 1); PG8_STAGE(PG8_SB(1, 0), b3, voffB); PG8_STAGE(PG8_SB(1, 1), b3 + hstepB, voffB); PG8_STAGE(PG8_SA(1, 0), a3, voffA);
            PG8_WAIT_V(8); PG8_WAIT_L(0); PG8_BAR; PG8_MMA(1, 0, At, B0); PG8_MMA(1, 1, At, B1); PG8_BAR; PG8_SCHED;
        }
        if constexpr (ALIGN_EPI) { if (wr == 0) PG8_BAR; }
        E(acc, cur, wr, wc, fr, fq);
        if (!has_next) break;
#pragma unroll
        for (int a = 0; a < 2; ++a)
#pragma unroll
            for (int b = 0; b < 2; ++b)
#pragma unroll
                for (int m = 0; m < 4; ++m)
#pragma unroll
                    for (int n = 0; n < 2; ++n) acc[a][b][m][n] = (f32x4){0.f, 0.f, 0.f, 0.f};
        cur = nxt; cA = nA; cB = nB; ++ui;
        if constexpr (ALIGN_EPI) { if (wr == 1) PG8_BAR; }
    }
    PG8_WAIT_V(0);
    if constexpr (!ALIGN_EPI) { if (wr == 0) PG8_BAR; }
    PG8_BAR;
#undef PG8_SA
#undef PG8_SB
#undef PG8_STAGE
#undef PG8_LDA
#undef PG8_LDB
#undef PG8_MMA
#undef PG8_WAIT_V
#undef PG8_WAIT_L
#undef PG8_BAR
#undef PG8_SCHED
}
}


#define XB_TMO      128
#define XB_XCNT(j)  (256  + 64 * (j))
#define XB_XSUB(j)  (1280 + 64 * (j))
#define XB_XGEN(j)  (2304 + 64 * (j))
#define XB_TOP      3328
#define XB_TOPGEN   3392
#define XCD_BAR_WORDS 3456
#define XB_SPIN_CAP (1u << 18)
__device__ __forceinline__ unsigned xb_ld(unsigned* p)              { return __hip_atomic_load(p, __ATOMIC_RELAXED, __HIP_MEMORY_SCOPE_AGENT); }
__device__ __forceinline__ unsigned xb_add(unsigned* p, unsigned v) { return __hip_atomic_fetch_add(p, v, __ATOMIC_RELAXED, __HIP_MEMORY_SCOPE_AGENT); }
__device__ __forceinline__ unsigned xb_xcc_id() { return (unsigned)__builtin_amdgcn_s_getreg((3 << 11) | 20) & 0xFu; }
#define XB_SPIN(cond, bar) do { unsigned _sp = 0; while (cond) { __builtin_amdgcn_s_sleep(1); \
    if ((++_sp & 255u) == 0u) { if (xb_ld(&(bar)[XB_TMO])) break; if (_sp > XB_SPIN_CAP) { atomicAdd(&(bar)[XB_TMO], 1u); break; } } } } while (0)
struct XcdBarrier { unsigned* bar; unsigned x; volatile LAS unsigned* st; };
__device__ __forceinline__ XcdBarrier xcd_barrier_post(unsigned* bar, volatile LAS unsigned* st) {
    XcdBarrier b; b.bar = bar; b.x = xb_xcc_id(); b.st = st;
    if (threadIdx.x == 0) (void)xb_add(&bar[XB_XCNT(b.x)], 1u);
    return b;
}
__device__ __forceinline__ void xcd_barrier_complete(unsigned* bar, unsigned x, unsigned& nloc, unsigned& nx) {
    const unsigned G = gridDim.x * gridDim.y * gridDim.z;
    unsigned sum, cnt, mine, sp = 0u;
    for (;;) {
        sum = 0u; cnt = 0u; mine = 0u;
#pragma unroll
        for (unsigned j = 0; j < 16; ++j) { const unsigned c = xb_ld(&bar[XB_XCNT(j)]); sum += c; cnt += (c > 0u) ? 1u : 0u; mine = (j == x) ? c : mine; }
        if (sum == G) break;
        __builtin_amdgcn_s_sleep(1);
        if ((++sp & 255u) == 0u) { if (xb_ld(&bar[XB_TMO])) break; if (sp > XB_SPIN_CAP) { atomicAdd(&bar[XB_TMO], 1u); break; } }
    }
    nloc = mine > 0u ? mine : 1u; nx = cnt > 0u ? cnt : 1u;
}
__device__ __forceinline__ void xcd_barrier(const XcdBarrier& b) {
    asm volatile("s_waitcnt vmcnt(0)" ::: "memory");
    __syncthreads();
    if (threadIdx.x == 0) {
        unsigned* bar = b.bar;
        __builtin_amdgcn_s_waitcnt(0);
        unsigned nloc = b.st[0], nx = b.st[1];
        if (nloc == 0u) { xcd_barrier_complete(bar, b.x, nloc, nx); b.st[0] = nloc; b.st[1] = nx; }
        const unsigned old = xb_add(&bar[XB_XSUB(b.x)], 1u);
        const unsigned gen = old / nloc;
        if (old + 1u == (gen + 1u) * nloc) {
            __builtin_amdgcn_fence(__ATOMIC_RELEASE, "agent");
            asm volatile("s_waitcnt vmcnt(0)" ::: "memory");
            const unsigned og = xb_add(&bar[XB_TOP], 1u);
            const unsigned tg = og / nx;
            if (og + 1u == (tg + 1u) * nx) xb_add(&bar[XB_TOPGEN], 1u);
            else XB_SPIN(xb_ld(&bar[XB_TOPGEN]) == tg, bar);
            __builtin_amdgcn_fence(__ATOMIC_ACQUIRE, "agent");
            xb_add(&bar[XB_XGEN(b.x)], 1u);
            asm volatile("s_waitcnt vmcnt(0)" ::: "memory");
        } else {
            XB_SPIN(xb_ld(&bar[XB_XGEN(b.x)]) == gen, bar);
            __builtin_amdgcn_fence(__ATOMIC_ACQUIRE, "agent");
            asm volatile("s_waitcnt vmcnt(0)" ::: "memory");
        }
    }
    __syncthreads();
}
struct Args { const float* in[21]; float* out; unsigned char* ws; int pad0, pad1; };
#define LDS_WAIT() asm volatile("s_waitcnt lgkmcnt(0)" ::: "memory")
#define GRID_SYNC() xcd_barrier(xbar)

__device__ __forceinline__ int dest_row(int mode, int n) {
    if (mode == 1) { const int half = n >= DFF ? 1 : 0; const int j = n - half * DFF; return ((j >> 7) << 8) + (half << 7) + (j & 127); }
    if (mode == 2) { if (n < 1024 || (n >= 3072 && n < 4096)) { const int d = n & 127, half = d >> 6, dd = d & 63, i = dd & 31, nb = dd >> 5, rho = 32 * half + i;
            return (n & ~127) + 32 * (rho >> 4) + 8 * ((rho >> 2) & 3) + 4 * nb + (rho & 3); } return n; }
    return n;
}
__device__ __forceinline__ void tr_item(const float* W, int K, int N, bf16_t* WT, int row_off, int mode, LAS float* scr, int item, int lane) {
    const int nblk = N >> 6, kb = item / nblk, nb = item - kb * nblk, k0 = kb << 6, n0 = nb << 6;
    f32x4 v[16];
#pragma unroll
    for (int i = 0; i < 16; ++i) { const int idx = i * 64 + lane, kk = idx >> 4, c4 = idx & 15; v[i] = *(const f32x4*)(W + (size_t)(k0 + kk) * N + n0 + 4 * c4); }
#pragma unroll
    for (int i = 0; i < 16; ++i) { const int idx = i * 64 + lane, kk = idx >> 4, c4 = idx & 15; LAS float* s = scr + kk * 65 + 4 * c4; s[0] = v[i][0]; s[1] = v[i][1]; s[2] = v[i][2]; s[3] = v[i][3]; }
    LDS_WAIT(); asm volatile("" ::: "memory");
    const int c = lane & 7;
#pragma unroll
    for (int j = 0; j < 8; ++j) { const int n = (lane >> 3) + 8 * j; const LAS float* s = scr + (8 * c) * 65 + n;
        u32x4 o; o.x = pk2(s[0], s[65]); o.y = pk2(s[2 * 65], s[3 * 65]); o.z = pk2(s[4 * 65], s[5 * 65]); o.w = pk2(s[6 * 65], s[7 * 65]);
        *(u32x4*)(WT + (size_t)(row_off + dest_row(mode, n0 + n)) * K + k0 + 8 * c) = o; }
    LDS_WAIT(); asm volatile("" ::: "memory");
}

__device__ __forceinline__ void norm_rows(const float* src_lat, const float* src_ctx, int nrows, const float* gvec, const float* mod, int shidx, int scidx, bf16_t* dst, int gw, int NGW, int lane, const float* part = nullptr, int npart = 0) {
    for (int r = gw; r < nrows; r += NGW) {
        const float* src = r < NLAT ? src_lat + (size_t)r * DM : src_ctx + (size_t)(r - NLAT) * DM;
        const int bsel = r < SEQ ? 0 : (r < NLAT ? 1 : 2);
        const f32x4* s4 = (const f32x4*)src + lane;
        f32x4 v[8]; float ss = 0.f;
#pragma unroll
        for (int j = 0; j < 8; ++j) v[j] = s4[64 * j];
        if (r >= NLAT && npart > 0) { const f32x4* p4 = (const f32x4*)(part + (size_t)(r - NLAT) * DM) + lane;
            for (int p = 0; p < npart; ++p) {
#pragma unroll
                for (int j = 0; j < 8; ++j) v[j] += p4[(size_t)p * (NCTX * DM / 4) + 64 * j]; } }
#pragma unroll
        for (int j = 0; j < 8; ++j) ss += (v[j][0] * v[j][0] + v[j][1] * v[j][1]) + (v[j][2] * v[j][2] + v[j][3] * v[j][3]);
        const float rstd = 1.0f / sqrtf(wave_sum(ss) * (1.0f / DM) + 1e-6f);
        const f32x4* g4 = (const f32x4*)gvec + lane; const f32x4* sc4 = (const f32x4*)(mod + bsel * NMOD + scidx * DM) + lane; const f32x4* sh4 = (const f32x4*)(mod + bsel * NMOD + shidx * DM) + lane;
        u32x2* o8 = (u32x2*)(dst + (size_t)r * DM) + lane;
#pragma unroll
        for (int j = 0; j < 8; ++j) { const f32x4 y = v[j] * rstd * g4[64 * j]; const f32x4 o = y * (sc4[64 * j] + 1.0f) + sh4[64 * j]; u32x2 w; w.x = pk2(o[0], o[1]); w.y = pk2(o[2], o[3]); o8[64 * j] = w; }
    }
}

__device__ __forceinline__ s16x4 lds_tr(const LAS unsigned char* p) { return __builtin_amdgcn_ds_read_tr16_b64_v4i16((LAS s16x4*)p); }
__device__ __forceinline__ bf16x8 lds_tr8(const LAS unsigned char* base, int pitch, int k0, int n0, int lane) {
    const int g = lane >> 4, q = (lane & 15) >> 2, p = lane & 3;
    const LAS unsigned char* a = base + (k0 + 8 * g + q) * pitch + (n0 + 4 * p) * 2;
    const s16x4 lo = lds_tr(a), hi = lds_tr(a + 4 * pitch);
    return (bf16x8){lo[0], lo[1], lo[2], lo[3], hi[0], hi[1], hi[2], hi[3]};
}
__device__ __forceinline__ float log2_gamma(const float* decay_logit, int dir, int h) { const float x = decay_logit[dir * 8 + h]; return -log1pf(expf(-x)) * LOG2E; }
__device__ __forceinline__ int slot_row0(int b, int slot) { return slot < 2 ? NLAT + b * CTXL + slot * 128 : b * SEQ + (slot - 2) * 128; }

__device__ __forceinline__ void r1_task(LAS unsigned char* lds, int task, const bf16_t* Kg, const bf16_t* Vg, bf16_t* KVS, const float* decay_logit) {
    int tid = threadIdx.x; asm volatile("" : "+v"(tid));
    const int lane = tid & 63, w = tid >> 6, g = lane >> 4, r16 = lane & 15;
    const int bh = task / NSLOT, slot = task - bh * NSLOT, b = bh >> 3, h = bh & 7, row0 = slot_row0(b, slot);
    const float l2f = log2_gamma(decay_logit, 0, h), l2b = log2_gamma(decay_logit, 1, h);
    LAS unsigned char* VS = lds; LAS unsigned char* KF = lds + 67584; LAS unsigned char* KB = lds + 67584 + 34816;
#pragma unroll
    for (int it = 0; it < 8; ++it) { const int p = tid + it * 512, r = p >> 5, cc = p & 31; *(LAS u32x4*)(VS + r * 528 + cc * 16) = *(const u32x4*)(Vg + (size_t)(row0 + r) * DM + h * 256 + cc * 8); }
#pragma unroll
    for (int it = 0; it < 4; ++it) { const int p = tid + it * 512, r = p >> 4, cc = p & 15; const u32x4 kv = *(const u32x4*)(Kg + (size_t)(row0 + r) * 1024 + h * 128 + cc * 8);
        const float wf = __builtin_amdgcn_exp2f(l2f * (float)(127 - r)), wb = __builtin_amdgcn_exp2f(l2b * (float)r);
        u32x4 of, ob;
        of.x = pk2(bflo(kv.x) * wf, bfhi(kv.x) * wf); of.y = pk2(bflo(kv.y) * wf, bfhi(kv.y) * wf); of.z = pk2(bflo(kv.z) * wf, bfhi(kv.z) * wf); of.w = pk2(bflo(kv.w) * wf, bfhi(kv.w) * wf);
        ob.x = pk2(bflo(kv.x) * wb, bfhi(kv.x) * wb); ob.y = pk2(bflo(kv.y) * wb, bfhi(kv.y) * wb); ob.z = pk2(bflo(kv.z) * wb, bfhi(kv.z) * wb); ob.w = pk2(bflo(kv.w) * wb, bfhi(kv.w) * wb);
        *(LAS u32x4*)(KF + r * 272 + cc * 16) = of; *(LAS u32x4*)(KB + r * 272 + cc * 16) = ob; }
    __syncthreads();
#pragma unroll 1
    for (int dir = 0; dir < 2; ++dir) {
        const LAS unsigned char* KW = dir == 0 ? KF : KB;
        f32x4 af[8][2];
#pragma unroll
        for (int mb = 0; mb < 8; ++mb)
#pragma unroll
            for (int nb = 0; nb < 2; ++nb) af[mb][nb] = (f32x4){0.f, 0.f, 0.f, 0.f};
#pragma unroll
        for (int ks = 0; ks < 4; ++ks) {
            bf16x8 bv[2];
#pragma unroll
            for (int nb = 0; nb < 2; ++nb) bv[nb] = lds_tr8(VS, 528, 32 * ks, 32 * w + 16 * nb, lane);
#pragma unroll
            for (int mb = 0; mb < 8; ++mb) { const bf16x8 kf = lds_tr8(KW, 272, 32 * ks, 16 * mb, lane);
#pragma unroll
                for (int nb = 0; nb < 2; ++nb) af[mb][nb] = __builtin_amdgcn_mfma_f32_16x16x32_bf16(kf, bv[nb], af[mb][nb], 0, 0, 0); }
            __builtin_amdgcn_sched_barrier(0);
        }
        bf16_t* of_ = KVS + ((size_t)(bh * NSLOT + slot) * 2 + dir) * 32768;
#pragma unroll
        for (int mb = 0; mb < 8; ++mb)
#pragma unroll
            for (int nb = 0; nb < 2; ++nb) { const int e = 32 * w + 16 * nb + r16, d = 16 * mb + 4 * g; u32x2 o;
                o.x = pk2(af[mb][nb][0], af[mb][nb][1]); o.y = pk2(af[mb][nb][2], af[mb][nb][3]); *(u32x2*)(of_ + e * 128 + d) = o; }
    }
    __syncthreads();
}

__device__ __forceinline__ void r3_task(LAS unsigned char* lds, int task, const bf16_t* Qg, const bf16_t* Kg, const bf16_t* Vg, const bf16_t* KVS, const bf16_t* Gs, bf16_t* ZA, const float* decay_logit) {
    int tid = threadIdx.x; asm volatile("" : "+v"(tid));
    const int lane = tid & 63, w = tid >> 6, g = lane >> 4, r16 = lane & 15;
    const int bh = task >> 5, c = task & 31, b = bh >> 3, h = bh & 7, row0 = b * SEQ + c * 128;
    const float l2f = log2_gamma(decay_logit, 0, h), l2b = log2_gamma(decay_logit, 1, h);
    LAS unsigned char* QS = lds; LAS unsigned char* KS = lds + 34816; LAS unsigned char* CS = lds + 69632;
#pragma unroll
    for (int it = 0; it < 4; ++it) { const int p = tid + it * 512, r = p >> 4, cc = p & 15;
        *(LAS u32x4*)(QS + r * 272 + cc * 16) = *(const u32x4*)(Qg + (size_t)(row0 + r) * 1024 + h * 128 + cc * 8);
        *(LAS u32x4*)(KS + r * 272 + cc * 16) = *(const u32x4*)(Kg + (size_t)(row0 + r) * 1024 + h * 128 + cc * 8); }
#pragma unroll
    for (int it = 0; it < 8; ++it) { const int p = tid + it * 512, r = p >> 5, cc = p & 31; *(LAS u32x4*)(CS + r * 528 + cc * 16) = *(const u32x4*)(Vg + (size_t)(row0 + r) * DM + h * 256 + cc * 8); }
    __syncthreads();
    f32x4 pa[8];
#pragma unroll
    for (int mb = 0; mb < 8; ++mb) pa[mb] = (f32x4){0.f, 0.f, 0.f, 0.f};
    bf16x8 qf[4];
#pragma unroll
    for (int ks = 0; ks < 4; ++ks) qf[ks] = *(const LAS bf16x8*)(QS + (16 * w + r16) * 272 + (32 * ks + 8 * g) * 2);
#pragma unroll
    for (int ks = 0; ks < 4; ++ks)
#pragma unroll
        for (int mb = 0; mb < 8; ++mb) { const bf16x8 kf = *(const LAS bf16x8*)(KS + (16 * mb + r16) * 272 + (32 * ks + 8 * g) * 2); pa[mb] = __builtin_amdgcn_mfma_f32_16x16x32_bf16(kf, qf[ks], pa[mb], 0, 0, 0); }
    {   const int i = 16 * w + r16;
#pragma unroll
        for (int mb = 0; mb < 8; ++mb)
#pragma unroll
            for (int jj = 0; jj < 4; ++jj) { const int j = 16 * mb + 4 * g + jj; const int dd = i - j;
                const float f = dd > 0 ? __builtin_amdgcn_exp2f(l2f * (float)dd) : (dd < 0 ? __builtin_amdgcn_exp2f(l2b * (float)(-dd)) : 2.0f); pa[mb][jj] *= f; }
    }
    __syncthreads();
#pragma unroll
    for (int mb = 0; mb < 8; ++mb) { u32x2 o; o.x = pk2(pa[mb][0], pa[mb][1]); o.y = pk2(pa[mb][2], pa[mb][3]); *(LAS u32x2*)(KS + (16 * w + r16) * 272 + (16 * mb + 4 * g) * 2) = o; }
    LDS_WAIT(); asm volatile("" ::: "memory");
    f32x4 acc[16];
#pragma unroll
    for (int nb = 0; nb < 16; ++nb) acc[nb] = (f32x4){0.f, 0.f, 0.f, 0.f};
#pragma unroll
    for (int ks = 0; ks < 4; ++ks) { const bf16x8 pf = *(const LAS bf16x8*)(KS + (16 * w + r16) * 272 + (32 * ks + 8 * g) * 2);
#pragma unroll
        for (int nb = 0; nb < 16; ++nb) { const bf16x8 vf = lds_tr8(CS, 528, 32 * ks, 16 * nb, lane); acc[nb] = __builtin_amdgcn_mfma_f32_16x16x32_bf16(pf, vf, acc[nb], 0, 0, 0); if ((nb & 3) == 3) __builtin_amdgcn_sched_barrier(0); } }
#pragma unroll 1
    for (int dir = 0; dir < 2; ++dir) {
        __syncthreads();
        const bf16_t* Sg = KVS + ((size_t)(bh * NSLOT + c + 2) * 2 + dir) * 32768;
#pragma unroll
        for (int it = 0; it < 8; ++it) { const int p = tid + it * 512, r = p >> 4, cc = p & 15; *(LAS u32x4*)(CS + r * 272 + cc * 16) = *(const u32x4*)(Sg + (size_t)r * 128 + cc * 8); }
        __syncthreads();
        const int ia = 16 * w + r16; const float sf = dir == 0 ? __builtin_amdgcn_exp2f(l2f * (float)(ia + 1)) : __builtin_amdgcn_exp2f(l2b * (float)(128 - ia));
#pragma unroll
        for (int ks = 0; ks < 4; ++ks) { bf16x8 qs; const bf16x8 q0 = *(const LAS bf16x8*)(QS + (16 * w + r16) * 272 + (32 * ks + 8 * g) * 2);
#pragma unroll
            for (int e = 0; e < 8; e += 2) { const unsigned pk = pk2(bf1(q0[e]) * sf, bf1(q0[e + 1]) * sf); qs[e] = (short)(pk & 0xffffu); qs[e + 1] = (short)(pk >> 16); }
#pragma unroll
            for (int nb = 0; nb < 16; ++nb) { const bf16x8 sfr = *(const LAS bf16x8*)(CS + (16 * nb + r16) * 272 + (32 * ks + 8 * g) * 2); acc[nb] = __builtin_amdgcn_mfma_f32_16x16x32_bf16(qs, sfr, acc[nb], 0, 0, 0); if ((nb & 3) == 3) __builtin_amdgcn_sched_barrier(0); } }
    }
#pragma unroll
    for (int jj = 0; jj < 4; ++jj) {
        float s = 0.f;
#pragma unroll
        for (int nb = 0; nb < 16; ++nb) s += acc[nb][jj];
        s += __shfl_xor(s, 1); s += __shfl_xor(s, 2); s += __shfl_xor(s, 4); s += __shfl_xor(s, 8);
        const float mu = s * (1.0f / 256.0f); float q = 0.f;
#pragma unroll
        for (int nb = 0; nb < 16; ++nb) { const float d = acc[nb][jj] - mu; q += d * d; }
        q += __shfl_xor(q, 1); q += __shfl_xor(q, 2); q += __shfl_xor(q, 4); q += __shfl_xor(q, 8);
        const float rstd = 1.0f / sqrtf(q * (1.0f / 256.0f) + 1e-5f);
        const size_t ro = (size_t)(row0 + 16 * w + 4 * g + jj) * DM + h * 256 + r16;
#pragma unroll
        for (int nb = 0; nb < 16; ++nb) { const float gs = __builtin_bit_cast(float, ((unsigned)Gs[ro + 16 * nb]) << 16); ZA[ro + 16 * nb] = (bf16_t)f2bf(gs * (acc[nb][jj] - mu) * rstd); }
    }
    __syncthreads();
}

__global__ void __launch_bounds__(512, 2) fwd_megakernel(Args args) {
    extern __shared__ __attribute__((aligned(16))) unsigned char lds_raw[];
    LAS unsigned char* lds = (LAS unsigned char*)lds_raw;
    cg::grid_group grid = cg::this_grid();
    const int tid = threadIdx.x, lane = tid & 63, wave = __builtin_amdgcn_readfirstlane(tid >> 6);
    const int G = gridDim.x, bx = blockIdx.x;
    const int gw = bx * 8 + wave, NGW = G * 8;
    unsigned char* ws = args.ws;
    const float* x = args.in[0]; const float* cvec = args.in[1]; const float* ctx = args.in[2]; const float* cctx = args.in[3];
    const float* w_ada = args.in[4]; const float* b_ada = args.in[5]; const float* norm_g = args.in[6];
    const float* decay_logit = args.in[12]; const float* pool_scale = args.in[14]; const float* b_gate = args.in[18]; const float* final_g = args.in[20];
    float* out = args.out;
    float* MOD = (float*)(ws + WS_MOD); float* ROPE = (float*)(ws + WS_ROPE);
    bf16_t* W13A = (bf16_t*)(ws + WS_W13A); bf16_t* W2A = (bf16_t*)(ws + WS_W2A); bf16_t* W13B = (bf16_t*)(ws + WS_W13B); bf16_t* W2B = (bf16_t*)(ws + WS_W2B);
    bf16_t* WIN = (bf16_t*)(ws + WS_WIN); bf16_t* WOA = (bf16_t*)(ws + WS_WOA); bf16_t* WOB = (bf16_t*)(ws + WS_WOB); bf16_t* WOUT = (bf16_t*)(ws + WS_WOUT); bf16_t* POOLW = (bf16_t*)(ws + WS_POOLW);
    bf16_t* AN = (bf16_t*)(ws + WS_AN); bf16_t* H = (bf16_t*)(ws + WS_H); float* HC1 = (float*)(ws + WS_HC1);
    bf16_t* Kb = (bf16_t*)(ws + WS_K); bf16_t* Qb = (bf16_t*)(ws + WS_Q); bf16_t* Vb = (bf16_t*)(ws + WS_V); bf16_t* Gb = (bf16_t*)(ws + WS_G); bf16_t* PIN = (bf16_t*)(ws + WS_PIN);
    bf16_t* GA = (bf16_t*)(ws + WS_GA); bf16_t* GB = (bf16_t*)(ws + WS_GB); bf16_t* POOLED = (bf16_t*)(ws + WS_POOLED); bf16_t* PM = (bf16_t*)(ws + WS_PM);
    bf16_t* KVS = H; float* T1 = (float*)H; bf16_t* ZA = AN; bf16_t* MMb = Gb;

#ifdef PROBE_A
    unsigned long long t_probe0 = 0, t_probe1 = 0;
#define PSTAMP(k, var) do { if ((k) == PROBE_A) var = __builtin_amdgcn_s_memrealtime(); } while (0)
#define PSTAMP2(k, var) do { if ((k) == PROBE_B) var = __builtin_amdgcn_s_memrealtime(); } while (0)
#else
#define PSTAMP(k, var) do {} while (0)
#define PSTAMP2(k, var) do {} while (0)
#endif
    volatile LAS unsigned* xst = (volatile LAS unsigned*)(lds + LDS_BYTES - 64);
    if (tid < 2) xst[tid] = 0u;
    __syncthreads();
    const XcdBarrier xbar = xcd_barrier_post((unsigned*)(ws + WS_BAR), xst);
    if (args.pad0 == 0x5a5a5a5a) grid.sync();
    PSTAMP(0, t_probe0); PSTAMP2(0, t_probe1);
    {
        LAS float* scr = (LAS float*)(lds + wave * 16640);
        constexpr int I_13 = 32 * 176, I_2 = 88 * 32, I_IN = 32 * 112, I_GT = 32 * 64, I_OA = 32 * 32, I_OB = 16 * 32, I_OUT = 32 * 32, I_PW = 16;
        constexpr int NIT = 2 * I_13 + 2 * I_2 + I_IN + I_GT + I_OA + I_OB + I_OUT + 4 * I_PW;
        for (int it = gw; it < NIT; it += NGW) {
            int r = it;
            if (r < I_13) { tr_item(args.in[7], DM, 2 * DFF, W13A, 0, 1, scr, r, lane); continue; } r -= I_13;
            if (r < I_13) { tr_item(args.in[9], DM, 2 * DFF, W13B, 0, 1, scr, r, lane); continue; } r -= I_13;
            if (r < I_2) { tr_item(args.in[8], DFF, DM, W2A, 0, 0, scr, r, lane); continue; } r -= I_2;
            if (r < I_2) { tr_item(args.in[10], DFF, DM, W2B, 0, 0, scr, r, lane); continue; } r -= I_2;
            if (r < I_IN) { tr_item(args.in[11], DM, 7168, WIN, 0, 2, scr, r, lane); continue; } r -= I_IN;
            if (r < I_GT) { tr_item(args.in[17], DM, 4096, WIN, 7168, 0, scr, r, lane); continue; } r -= I_GT;
            if (r < I_OA) { tr_item(args.in[15], DM, DM, WOA, 0, 0, scr, r, lane); continue; } r -= I_OA;
            if (r < I_OB) { tr_item(args.in[16], 1024, DM, WOB, 0, 0, scr, r, lane); continue; } r -= I_OB;
            if (r < I_OUT) { tr_item(args.in[19], DM, DM, WOUT, 0, 0, scr, r, lane); continue; } r -= I_OUT;
            { const int gp = r >> 4; tr_item(args.in[13] + (size_t)gp * 65536, 256, 256, POOLW + (size_t)gp * 65536, 0, 0, scr, r & 15, lane); }
        }
        for (int it = gw; it < 72 * 32; it += NGW) {
            const int cgp = it % 72, kc = it / 72, col = cgp * 256 + lane * 4, k = kc * 64 + lane;
            const float s0 = fsilu(cvec[k]), s1 = fsilu(cvec[DM + k]), s2 = fsilu(cctx[k]);
            f32x4 a0 = {0.f, 0.f, 0.f, 0.f}, a1 = a0, a2 = a0;
#pragma unroll 16
            for (int kk = 0; kk < 64; ++kk) { const f32x4 wv = *(const f32x4*)(w_ada + (size_t)(kc * 64 + kk) * NMOD + col);
                a0 += wv * __shfl(s0, kk); a1 += wv * __shfl(s1, kk); a2 += wv * __shfl(s2, kk); }
            if (kc == 0) { const f32x4 bv = *(const f32x4*)(b_ada + col); a0 += bv; a1 += bv; a2 += bv; }
#pragma unroll
            for (int e = 0; e < 4; ++e) { __hip_atomic_fetch_add(MOD + col + e, a0[e], __ATOMIC_RELAXED, __HIP_MEMORY_SCOPE_AGENT); __hip_atomic_fetch_add(MOD + NMOD + col + e, a1[e], __ATOMIC_RELAXED, __HIP_MEMORY_SCOPE_AGENT);
                __hip_atomic_fetch_add(MOD + 2 * NMOD + col + e, a2[e], __ATOMIC_RELAXED, __HIP_MEMORY_SCOPE_AGENT); }
        }
        { const int id = bx * 512 + tid; if (id < 2048) { const int pos = id >> 5, i = id & 31; const float inv = powf(10000.0f, -(float)i * (1.0f / 32.0f)); const float ang = (float)pos * inv; ROPE[2 * id] = cosf(ang); ROPE[2 * id + 1] = sinf(ang); } }
    }
    GRID_SYNC();
#if defined(STOP) && STOP == 100
    for (size_t i = (size_t)bx * 512 + tid; i < (size_t)NLAT * DM; i += (size_t)G * 512) out[i] = bf1((short)WIN[i]) + (i + (size_t)NLAT * DM < (size_t)11264 * 2048 ? bf1((short)WIN[i + (size_t)NLAT * DM]) : 0.f);
    return;
#endif
    PSTAMP(1, t_probe0); PSTAMP2(1, t_probe1);
    norm_rows(x, ctx, MT, norm_g, MOD, 0, 1, AN, gw, NGW, lane);
    GRID_SYNC();
    PSTAMP(2, t_probe0); PSTAMP2(2, t_probe1);
    { pg8::Gemm g{AN, W13A, DM, DM}; pg8::MixOrder S; S.init(32, 44, 2, 44, G, bx, 32); pg8::EpiSwiglu E{H, DFF}; pg8::gemm_phase<pg8::EpiSwiglu, pg8::MixOrder, true>(lds, g, S, E); }
    GRID_SYNC();
    PSTAMP(3, t_probe0); PSTAMP2(3, t_probe1);
    { pg8::Gemm g{H, W2A, DFF, DFF}; pg8::MixOrder S; S.init(32, 8, 2, 8, G, bx, 88, 11); pg8::EpiResid E{x, out, (float*)(ws + WS_K), MOD, 2, 0.5f}; pg8::gemm_phase<pg8::EpiResid, pg8::MixOrder, true>(lds, g, S, E); }
    GRID_SYNC();
#if defined(STOP) && STOP == 3
    return;
#endif
    PSTAMP(4, t_probe0); PSTAMP2(4, t_probe1);
    norm_rows(out, ctx, MT, norm_g + DM, MOD, 3, 4, AN, gw, NGW, lane, (const float*)(ws + WS_K), 11);
    GRID_SYNC();
#if defined(STOP) && STOP == 4
    for (size_t i = (size_t)bx * 512 + tid; i < (size_t)NLAT * DM; i += (size_t)G * 512) out[i] = bf1((short)AN[i]) + ((i >> 11) < 512 ? bf1((short)AN[i + (size_t)NLAT * DM]) : 0.f);
    return;
#endif
    PSTAMP(5, t_probe0); PSTAMP2(5, t_probe1);
    { pg8::Gemm g{AN, WIN, DM, DM}; pg8::MixOrder S; S.init(32, 44, 2, 12, G, bx, 32); pg8::EpiIn E{Kb, Qb, Vb, Gb, PIN, GA, GB, b_gate, ROPE}; pg8::gemm_phase<pg8::EpiIn, pg8::MixOrder, true>(lds, g, S, E); }
    GRID_SYNC();
#if defined(STOP) && STOP == 5
    for (size_t i = (size_t)bx * 512 + tid; i < (size_t)NLAT * DM; i += (size_t)G * 512) { const size_t r = i >> 11, c = i & 2047; out[i] = bf1((short)Kb[r * 1024 + (c & 1023)]) + bf1((short)Qb[r * 1024 + (c & 1023)]) + bf1((short)Vb[i]) + bf1((short)Gb[i]) + bf1((short)PIN[r * 1024 + (c & 1023)]) + bf1((short)GA[i]) + bf1((short)GB[i]); }
    return;
#endif
    PSTAMP(6, t_probe0); PSTAMP2(6, t_probe1);
    for (int t = bx; t < 16 * NSLOT; t += G) r1_task(lds, t, Kb, Vb, KVS, decay_logit);
    for (int it = bx * 512 + tid; it < NLAT * 128; it += G * 512) {
        const int r = it >> 7, pc = it & 127, gp = pc >> 5, win = 2 << gp, lo = win >> 1, hi = win - 1 - lo, t = r & (SEQ - 1), rb = r - t;
        const int st = t - lo < 0 ? 0 : t - lo, en = t + hi + 1 > SEQ ? SEQ : t + hi + 1;
        float s[8] = {0.f, 0.f, 0.f, 0.f, 0.f, 0.f, 0.f, 0.f};
        for (int q = st; q < en; ++q) { const u32x4 v = *(const u32x4*)(PIN + (size_t)(rb + q) * 1024 + pc * 8);
            s[0] += bflo(v.x); s[1] += bfhi(v.x); s[2] += bflo(v.y); s[3] += bfhi(v.y); s[4] += bflo(v.z); s[5] += bfhi(v.z); s[6] += bflo(v.w); s[7] += bfhi(v.w); }
        const float ic = 1.0f / (float)(en - st); const u32x4 v = *(const u32x4*)(PIN + (size_t)r * 1024 + pc * 8);
        u32x4 o; o.x = pk2(s[0] * ic - bflo(v.x), s[1] * ic - bfhi(v.x)); o.y = pk2(s[2] * ic - bflo(v.y), s[3] * ic - bfhi(v.y)); o.z = pk2(s[4] * ic - bflo(v.z), s[5] * ic - bfhi(v.z)); o.w = pk2(s[6] * ic - bflo(v.w), s[7] * ic - bfhi(v.w));
        *(u32x4*)(POOLED + (size_t)r * 1024 + pc * 8) = o;
    }
    GRID_SYNC();
    PSTAMP(7, t_probe0); PSTAMP2(7, t_probe1);
    for (int id = bx * 512 + tid; id < 16 * 2 * 4096; id += G * 512) {
        const int bh = id >> 13, dir = (id >> 12) & 1, off = (id & 4095) * 8, h = bh & 7;
        const float cd = __builtin_amdgcn_exp2f(log2_gamma(decay_logit, dir, h) * 128.0f);
        bf16_t* base = KVS + (size_t)bh * NSLOT * 65536 + dir * 32768 + off;
        float r[8] = {0.f, 0.f, 0.f, 0.f, 0.f, 0.f, 0.f, 0.f};
#pragma unroll 2
        for (int s = 0; s < NSLOT; ++s) {
            const int slot = dir == 0 ? s : (s == 0 ? 1 : (s == 1 ? 0 : NSLOT + 1 - s));
            u32x4* p = (u32x4*)(base + (size_t)slot * 65536); const u32x4 v = *p;
            u32x4 o; o.x = pk2(r[0], r[1]); o.y = pk2(r[2], r[3]); o.z = pk2(r[4], r[5]); o.w = pk2(r[6], r[7]); *p = o;
            r[0] = r[0] * cd + bflo(v.x); r[1] = r[1] * cd + bfhi(v.x); r[2] = r[2] * cd + bflo(v.y); r[3] = r[3] * cd + bfhi(v.y);
            r[4] = r[4] * cd + bflo(v.z); r[5] = r[5] * cd + bfhi(v.z); r[6] = r[6] * cd + bflo(v.w); r[7] = r[7] * cd + bfhi(v.w);
        }
    }
    { const int gp = (bx >> 5) & 3; pg8::Gemm g{POOLED + gp * 256, POOLW + (size_t)gp * 65536, 1024, 256}; pg8::MixOrder S; S.init(32, 1, 0, 1, 1 << 20, bx < 128 ? (bx & 31) : 32, 4);
        pg8::EpiPool E{PM, pool_scale, gp}; pg8::gemm_phase<pg8::EpiPool, pg8::MixOrder, true>(lds, g, S, E); }
    GRID_SYNC();
#if defined(STOP) && STOP == 7
    for (size_t i = (size_t)bx * 512 + tid; i < (size_t)NLAT * DM; i += (size_t)G * 512) { const size_t r = i >> 11, c = i & 2047; out[i] = bf1((short)POOLED[r * 1024 + (c & 1023)]) + bf1((short)PM[r * 1024 + (c & 1023)]) + bf1((short)KVS[i]) + bf1((short)KVS[i + (size_t)NLAT * DM]); }
    return;
#endif
    PSTAMP(8, t_probe0); PSTAMP2(8, t_probe1);
    for (int t = bx; t < 512; t += G) r3_task(lds, t, Qb, Kb, Vb, KVS, Gb, ZA, decay_logit);
    GRID_SYNC();
#if defined(STOP) && STOP == 8
    for (size_t i = (size_t)bx * 512 + tid; i < (size_t)NLAT * DM; i += (size_t)G * 512) out[i] = bf1((short)ZA[i]);
    return;
#endif
    PSTAMP(9, t_probe0); PSTAMP2(9, t_probe1);
    { pg8::Gemm g{ZA, WOA, DM, DM}; pg8::MixOrder S; S.init(32, 8, 0, 1, G, bx, 32); pg8::EpiMergeA E{T1, GA}; pg8::gemm_phase<pg8::EpiMergeA, pg8::MixOrder, true>(lds, g, S, E); }
    { pg8::Gemm g{PM, WOB, 1024, 1024}; pg8::MixOrder S; S.init(32, 8, 0, 1, G, bx, 16); pg8::EpiMergeB E{T1, GB, MMb}; pg8::gemm_phase<pg8::EpiMergeB, pg8::MixOrder, true>(lds, g, S, E); }
    GRID_SYNC();
#if defined(STOP) && STOP == 9
    for (size_t i = (size_t)bx * 512 + tid; i < (size_t)NLAT * DM; i += (size_t)G * 512) out[i] = bf1((short)MMb[i]);
    return;
#endif
    PSTAMP(10, t_probe0); PSTAMP2(10, t_probe1);
    { pg8::Gemm g{MMb, WOUT, DM, DM}; pg8::MixOrder S; S.init(32, 8, 0, 1, G, bx, 32); pg8::EpiResid E{out, out, out, MOD, 5, 1.0f}; pg8::gemm_phase<pg8::EpiResid, pg8::MixOrder, true>(lds, g, S, E); }
    GRID_SYNC();
    PSTAMP(11, t_probe0); PSTAMP2(11, t_probe1);
    norm_rows(out, out, NLAT, norm_g + 2 * DM, MOD, 6, 7, AN, gw, NGW, lane);
    GRID_SYNC();
    PSTAMP(12, t_probe0); PSTAMP2(12, t_probe1);
    { pg8::Gemm g{AN, W13B, DM, DM}; pg8::MixOrder S; S.init(32, 44, 0, 1, G, bx, 32); pg8::EpiSwiglu E{H, DFF}; pg8::gemm_phase<pg8::EpiSwiglu, pg8::MixOrder, true>(lds, g, S, E); }
    GRID_SYNC();
    PSTAMP(13, t_probe0); PSTAMP2(13, t_probe1);
    { pg8::Gemm g{H, W2B, DFF, DFF}; pg8::MixOrder S; S.init(32, 8, 0, 1, G, bx, 88); pg8::EpiResid E{out, out, out, MOD, 8, 0.5f}; pg8::gemm_phase<pg8::EpiResid, pg8::MixOrder, true>(lds, g, S, E); }
    GRID_SYNC();
    PSTAMP(14, t_probe0); PSTAMP2(14, t_probe1);
    for (int r = gw; r < NLAT; r += NGW) {
        f32x4* s4 = (f32x4*)(out + (size_t)r * DM) + lane;
        f32x4 v[8]; float ss = 0.f;
#pragma unroll
        for (int j = 0; j < 8; ++j) { v[j] = s4[64 * j]; ss += (v[j][0] * v[j][0] + v[j][1] * v[j][1]) + (v[j][2] * v[j][2] + v[j][3] * v[j][3]); }
        const float rstd = 1.0f / sqrtf(wave_sum(ss) * (1.0f / DM) + 1e-6f);
        const f32x4* g4 = (const f32x4*)final_g + lane;
#pragma unroll
        for (int j = 0; j < 8; ++j) s4[64 * j] = v[j] * rstd * g4[64 * j];
    }
#ifdef PROBE_A
    PSTAMP2(15, t_probe1);
    GRID_SYNC();
    if (bx == 0) { const unsigned long long dt = __shfl(t_probe1 - t_probe0, 0); const int n = (int)(dt / PDIV); for (int i = tid; i < n && i < 14000; i += 512) out[(size_t)i * 97 + 5] += 0.15f; }
#endif
}

extern "C" void kernel_launch(void* const* d_in, const int* in_sizes, int n_in, void* d_out, int out_size, void* d_ws, size_t ws_size, hipStream_t stream) {
    static int grid = 0;
    if (grid == 0) {
        if (n_in != 21 || out_size != NLAT * DM || ws_size < WS_END) { fprintf(stderr, "kernel_launch: unexpected shapes (n_in %d out %d ws %zu need %zu)\n", n_in, out_size, ws_size, (size_t)WS_END); grid = -1; return; }
        int dev = 0, cus = 0, per_cu = 0;
        (void)hipGetDevice(&dev);
        (void)hipDeviceGetAttribute(&cus, hipDeviceAttributeMultiprocessorCount, dev);
        (void)hipFuncSetAttribute((const void*)fwd_megakernel, hipFuncAttributeMaxDynamicSharedMemorySize, LDS_BYTES);
        (void)hipOccupancyMaxActiveBlocksPerMultiprocessor(&per_cu, (const void*)fwd_megakernel, 512, LDS_BYTES);
        (void)hipGetLastError();
        if (per_cu < 1) fprintf(stderr, "kernel_launch: occupancy query says %d blocks per CU\n", per_cu);
        grid = cus;
    }
    if (grid < 0) return;
    (void)hipMemsetAsync((char*)d_ws, 0, 512 * 1024, stream);
    Args a{};
    for (int i = 0; i < 21; ++i) a.in[i] = (const float*)d_in[i];
    a.out = (float*)d_out; a.ws = (unsigned char*)d_ws;
    void* kargs[] = {&a};
    hipError_t e = hipLaunchCooperativeKernel((const void*)fwd_megakernel, dim3(grid), dim3(512), kargs, LDS_BYTES, stream);
    if (e != hipSuccess) fprintf(stderr, "cooperative launch failed: %s (grid %d)\n", hipGetErrorString(e), grid);
}
```

```cpp
#include <hip/hip_runtime.h>
#include <hip/hip_cooperative_groups.h>
#include <cstdio>
#include <cstdint>
namespace cg = cooperative_groups;

#define LAS __attribute__((address_space(3)))
typedef unsigned short bf16_t;
typedef short bf16x8 __attribute__((ext_vector_type(8)));
typedef short s16x4 __attribute__((ext_vector_type(4)));
typedef float f32x4 __attribute__((ext_vector_type(4)));
typedef unsigned u32x4 __attribute__((ext_vector_type(4)));
typedef unsigned u32x2 __attribute__((ext_vector_type(2)));

constexpr int DM = 2048, SEQ = 4096, NLAT = 8192, NCTX = 512, MT = NLAT + NCTX, CTXL = 256;
constexpr int DFF = 5632, NMOD = 9 * DM;
constexpr int NSLOT = 34;
constexpr float LOG2E = 1.4426950408889634f;

constexpr size_t MiB = 1u << 20;
constexpr size_t WS_MOD = 0;
constexpr size_t WS_BAR = 256 * 1024;
constexpr size_t WS_ROPE = 512 * 1024;
constexpr size_t WS_W13A = 1 * MiB, WS_W2A = 45 * MiB, WS_W13B = 67 * MiB, WS_W2B = 111 * MiB, WS_WIN = 133 * MiB;
constexpr size_t WS_WOA = 177 * MiB, WS_WOB = 185 * MiB, WS_WOUT = 189 * MiB, WS_POOLW = 197 * MiB;
constexpr size_t WS_AN = 198 * MiB;
constexpr size_t WS_H = 232 * MiB;
constexpr size_t WS_HC1 = 326 * MiB;
constexpr size_t WS_K = 330 * MiB, WS_Q = 347 * MiB, WS_V = 363 * MiB, WS_G = 397 * MiB, WS_PIN = 429 * MiB, WS_GA = 445 * MiB, WS_GB = 477 * MiB;
constexpr size_t WS_POOLED = 509 * MiB, WS_PM = 525 * MiB, WS_END = 541 * MiB;
constexpr int LDS_BYTES = 147456;

__device__ __forceinline__ unsigned f2bf(float f) { unsigned u = __builtin_bit_cast(unsigned, f); return (u + 0x7fffu + ((u >> 16) & 1u)) >> 16; }
typedef float f32x2_t __attribute__((ext_vector_type(2))); typedef __bf16 bf16x2_t __attribute__((ext_vector_type(2)));
__device__ __forceinline__ unsigned pk2(float lo, float hi) { f32x2_t v = {lo, hi}; bf16x2_t b = __builtin_convertvector(v, bf16x2_t); return __builtin_bit_cast(unsigned, b); }
__device__ __forceinline__ float bflo(unsigned w) { return __builtin_bit_cast(float, w << 16); }
__device__ __forceinline__ float bfhi(unsigned w) { return __builtin_bit_cast(float, w & 0xffff0000u); }
__device__ __forceinline__ float bf1(short s) { return __builtin_bit_cast(float, ((unsigned)(unsigned short)s) << 16); }
__device__ __forceinline__ float fsilu(float a) { return a * __builtin_amdgcn_rcpf(1.0f + __builtin_amdgcn_exp2f(-a * LOG2E)); }
__device__ __forceinline__ float fsigm(float a) { return __builtin_amdgcn_rcpf(1.0f + __builtin_amdgcn_exp2f(-a * LOG2E)); }
__device__ __forceinline__ float wave_sum(float v) {
#pragma unroll
    for (int o = 1; o < 64; o <<= 1) v += __shfl_xor(v, o);
    return v;
}

namespace pg8 {
constexpr int BM = 256, BK = 64, HALF = 128, HTB = HALF * BK * 2, STAGE_BYTES = 8 * HTB, NXCD = 8, WGM = 8;
__device__ __forceinline__ int lds_byte(int r, int c) { const int st = (r >> 4) * 2 + (c >> 5), rr = r & 15, cc = c & 31, ob = rr * 64 + cc * 2; return st * 1024 + (ob ^ (((ob >> 9) & 1) << 5)); }
__device__ __forceinline__ void stage_rc(int b, int& R, int& C) { const int st = b / 1024, sb = b % 1024, swz = sb ^ (((sb >> 9) & 1) << 5); R = (st >> 1) * 16 + swz / 64; C = (st & 1) * 32 + (swz % 64) / 2; }
__device__ __forceinline__ int perm32(int rho) { const int n = rho >> 4, i = rho & 15; return 8 * (i >> 2) + 4 * n + (i & 3); }
struct Unit { int pm, pn, k0, nt; };
struct Gemm { const bf16_t* A; const bf16_t* Bt; int lda, ldb; };

struct MixOrder {
    int nMl, nN, nLat, nNc, nCtx, G, c, ntf, nsp, ntp;
    __device__ void init(int nMl_, int nN_, int nMc_, int nNc_, int G_, int c_, int ntf_, int nsp_ = 1) { nMl = nMl_; nN = nN_; nLat = nMl_ * nN_; nNc = nNc_; nsp = nsp_; nCtx = nMc_ * nNc_ * nsp_; G = G_; c = c_; ntf = ntf_; ntp = ntf_ / nsp_; }
    __device__ bool next(int i, Unit& u) const {
        long L = (long)i * G + c;
        if (L < nLat) {
            const int nwg = nLat, nM = nMl;
            int wgid = (int)L; { const int q = nwg / NXCD, r = nwg % NXCD, xcd = wgid % NXCD, off = wgid / NXCD; wgid = (xcd < r ? xcd * (q + 1) : r * (q + 1) + (xcd - r) * q) + off; }
            const int nig = WGM * nN, gid = wgid / nig, fm = gid * WGM, gsz = (nM - fm) < WGM ? (nM - fm) : WGM;
            u.pm = fm + ((wgid % nig) % gsz); u.pn = (wgid % nig) / gsz; u.k0 = 0; u.nt = ntf; return true;
        }
        L -= nLat;
        if (L < nCtx) { const int t = (int)(L / nsp), p = (int)(L % nsp); u.pm = nMl + t / nNc; u.pn = t % nNc; u.k0 = p * ntp; u.nt = ntp; return true; }
        return false;
    }
};

__device__ __forceinline__ unsigned cvt_pk_bf16(float lo, float hi) { return pk2(lo, hi); }
__device__ __forceinline__ u32x4 pack8(const f32x4 a, const f32x4 b) { u32x4 w; w.x = cvt_pk_bf16(a[0], a[1]); w.y = cvt_pk_bf16(a[2], a[3]); w.z = cvt_pk_bf16(b[0], b[1]); w.w = cvt_pk_bf16(b[2], b[3]); return w; }

struct EpiSwiglu {
    static constexpr bool PERM = true, HOOK = false;
    bf16_t* O; int ldc;
    __device__ __forceinline__ void operator()(const f32x4 (&acc)[2][2][4][2], const Unit& u, int wr, int wc, int fr, int fq) const {
        const int row0 = u.pm * BM + wr * 64 + fr, col0 = u.pn * HALF + wc * 32 + 8 * fq;
#pragma unroll
        for (int ai = 0; ai < 2; ++ai)
#pragma unroll
            for (int m = 0; m < 4; ++m) {
                f32x4 h0, h1;
#pragma unroll
                for (int e = 0; e < 4; ++e) { h0[e] = fsilu(acc[ai][0][m][0][e]) * acc[ai][1][m][0][e]; h1[e] = fsilu(acc[ai][0][m][1][e]) * acc[ai][1][m][1][e]; }
                *(u32x4*)(O + (size_t)(row0 + ai * HALF + m * 16) * ldc + col0) = pack8(h0, h1);
            }
    }
};
struct EpiResid {
    static constexpr bool PERM = false, HOOK = false;
    const float* res_lat; float* out_lat; float* out_ctx; const float* mod; int gidx; float scale;
    __device__ __forceinline__ void operator()(const f32x4 (&acc)[2][2][4][2], const Unit& u, int wr, int wc, int fr, int fq) const {
        const bool ctx = u.pm >= 32; const int bsel = ctx ? 2 : (u.pm >= 16 ? 1 : 0);
        const int row0 = (ctx ? (u.pm - 32) : u.pm) * BM + wr * 64 + fr, col0 = u.pn * BM + wc * 32 + 4 * fq;
        const float* gate = mod + bsel * NMOD + gidx * DM;
        f32x4 gv[2][2];
#pragma unroll
        for (int bj = 0; bj < 2; ++bj)
#pragma unroll
            for (int n = 0; n < 2; ++n) gv[bj][n] = *(const f32x4*)(gate + col0 + bj * HALF + n * 16) * scale;
        if (!ctx) {
#pragma unroll
            for (int ai = 0; ai < 2; ++ai)
#pragma unroll
                for (int m = 0; m < 4; ++m) { const size_t off = (size_t)(row0 + ai * HALF + m * 16) * DM + col0;
#pragma unroll
                    for (int bj = 0; bj < 2; ++bj)
#pragma unroll
                        for (int n = 0; n < 2; ++n) { const size_t o = off + bj * HALF + n * 16; const f32x4 r = *(const f32x4*)(res_lat + o); *(f32x4*)(out_lat + o) = r + gv[bj][n] * acc[ai][bj][m][n]; } }
        } else {
#pragma unroll
            for (int ai = 0; ai < 2; ++ai)
#pragma unroll
                for (int m = 0; m < 4; ++m) { const size_t off = (size_t)(row0 + ai * HALF + m * 16) * DM + col0;
#pragma unroll
                    for (int bj = 0; bj < 2; ++bj)
#pragma unroll
                        for (int n = 0; n < 2; ++n) *(f32x4*)(out_ctx + (size_t)(u.k0 / u.nt) * (NCTX * DM) + off + bj * HALF + n * 16) = gv[bj][n] * acc[ai][bj][m][n]; }
        }
    }
};
struct EpiIn {
    static constexpr bool PERM = true, HOOK = false;
    bf16_t *K, *Q, *V, *G, *PIN, *GA, *GB; const float* bgate; const float* rope;
    __device__ __forceinline__ void operator()(const f32x4 (&acc)[2][2][4][2], const Unit& u, int wr, int wc, int fr, int fq) const {
        const int row0 = u.pm * BM + wr * 64 + fr, cb = wc * 32 + 8 * fq, pn = u.pn;
        if (pn < 4 || (pn >= 12 && pn < 16)) {
            const bool isk = pn < 4; bf16_t* dst = isk ? K : Q; const int hcol = (isk ? pn : pn - 12) * BM; const float sc = isk ? 0.08838834764831845f : 1.0f;
            const bool lat = u.pm < 32; const int i0 = (16 * wc + 4 * fq) & 31;
#pragma unroll
            for (int ai = 0; ai < 2; ++ai)
#pragma unroll
                for (int m = 0; m < 4; ++m) {
                    const int row = row0 + ai * HALF + m * 16;
                    f32x4 cs0 = {1.f, 0.f, 1.f, 0.f}, cs1 = {1.f, 0.f, 1.f, 0.f};
                    if (lat) { const int t = row & 4095; const int pos = (wc < 2) ? (t >> 6) : (t & 63); const float* rp = rope + (pos * 32 + i0) * 2; cs0 = *(const f32x4*)rp; cs1 = *(const f32x4*)(rp + 4); }
                    const float c_[4] = {cs0[0], cs0[2], cs1[0], cs1[2]}, s_[4] = {cs0[1], cs0[3], cs1[1], cs1[3]};
#pragma unroll
                    for (int bj = 0; bj < 2; ++bj) { const f32x4 x1 = acc[ai][bj][m][0], x2 = acc[ai][bj][m][1]; f32x4 o1, o2;
#pragma unroll
                        for (int e = 0; e < 4; ++e) { o1[e] = (x1[e] * c_[e] - x2[e] * s_[e]) * sc; o2[e] = (x1[e] * s_[e] + x2[e] * c_[e]) * sc; }
                        *(u32x4*)(dst + (size_t)row * 1024 + hcol + bj * HALF + cb) = pack8(o1, o2); }
                }
        } else if (pn < 12) {
#pragma unroll
            for (int ai = 0; ai < 2; ++ai)
#pragma unroll
                for (int m = 0; m < 4; ++m)
#pragma unroll
                    for (int bj = 0; bj < 2; ++bj) *(u32x4*)(V + (size_t)(row0 + ai * HALF + m * 16) * DM + (pn - 4) * BM + bj * HALF + cb) = pack8(acc[ai][bj][m][0], acc[ai][bj][m][1]);
        } else if (pn < 24) {
#pragma unroll
            for (int ai = 0; ai < 2; ++ai)
#pragma unroll
                for (int m = 0; m < 4; ++m)
#pragma unroll
                    for (int bj = 0; bj < 2; ++bj) { f32x4 a = acc[ai][bj][m][0], b = acc[ai][bj][m][1];
#pragma unroll
                        for (int e = 0; e < 4; ++e) { a[e] = fsilu(a[e]); b[e] = fsilu(b[e]); }
                        *(u32x4*)(G + (size_t)(row0 + ai * HALF + m * 16) * DM + (pn - 16) * BM + bj * HALF + cb) = pack8(a, b); }
        } else if (pn < 28) {
#pragma unroll
            for (int ai = 0; ai < 2; ++ai)
#pragma unroll
                for (int m = 0; m < 4; ++m)
#pragma unroll
                    for (int bj = 0; bj < 2; ++bj) *(u32x4*)(PIN + (size_t)(row0 + ai * HALF + m * 16) * 1024 + (pn - 24) * BM + bj * HALF + cb) = pack8(acc[ai][bj][m][0], acc[ai][bj][m][1]);
        } else {
            const int gc = (pn - 28) * HALF + cb;
            const f32x4 a0 = *(const f32x4*)(bgate + gc), a1 = *(const f32x4*)(bgate + gc + 4), b0 = *(const f32x4*)(bgate + DM + gc), b1 = *(const f32x4*)(bgate + DM + gc + 4);
#pragma unroll
            for (int ai = 0; ai < 2; ++ai)
#pragma unroll
                for (int m = 0; m < 4; ++m) { const f32x4 xa0 = acc[ai][0][m][0] + a0, xa1 = acc[ai][0][m][1] + a1, xb0 = acc[ai][1][m][0] + b0, xb1 = acc[ai][1][m][1] + b1;
                    f32x4 r0, r1, g0, g1;
#pragma unroll
                    for (int e = 0; e < 4; ++e) { const float ea0 = 1.0f + __builtin_amdgcn_exp2f(-xa0[e] * LOG2E), ea1 = 1.0f + __builtin_amdgcn_exp2f(-xa1[e] * LOG2E), eb0 = 1.0f + __builtin_amdgcn_exp2f(-xb0[e] * LOG2E), eb1 = 1.0f + __builtin_amdgcn_exp2f(-xb1[e] * LOG2E);
                        r0[e] = eb0 * __builtin_amdgcn_rcpf(ea0); r1[e] = eb1 * __builtin_amdgcn_rcpf(ea1); g0[e] = __builtin_amdgcn_rcpf(eb0); g1[e] = __builtin_amdgcn_rcpf(eb1); }
                    const size_t o = (size_t)(row0 + ai * HALF + m * 16) * DM + gc;
                    *(u32x4*)(GA + o) = pack8(r0, r1); *(u32x4*)(GB + o) = pack8(g0, g1); }
        }
    }
};
struct EpiMerge {
    static constexpr bool PERM = true, HOOK = true;
    const bf16_t* RA; const bf16_t* GB; bf16_t* MM; int hook_t;
    __device__ __forceinline__ void hook(f32x4 (&acc)[2][2][4][2], const Unit& u, int wr, int wc, int fr, int fq) const {
        int row0 = u.pm * BM + wr * 64 + fr; const int col0 = u.pn * BM + wc * 32 + 8 * fq;
        asm volatile("" : "+v"(row0));
#pragma unroll
        for (int ai = 0; ai < 2; ++ai)
#pragma unroll
            for (int m = 0; m < 4; ++m)
#pragma unroll
                for (int bj = 0; bj < 2; ++bj) { const u32x4 g = *(const u32x4*)(RA + (size_t)(row0 + ai * HALF + m * 16) * DM + col0 + bj * HALF);
                    acc[ai][bj][m][0] *= (f32x4){bflo(g.x), bfhi(g.x), bflo(g.y), bfhi(g.y)}; acc[ai][bj][m][1] *= (f32x4){bflo(g.z), bfhi(g.z), bflo(g.w), bfhi(g.w)};
                    if (bj == 1 && (m & 1)) { asm volatile("" ::: "memory"); __builtin_amdgcn_sched_barrier(0); } }
    }
    __device__ __forceinline__ void operator()(const f32x4 (&acc)[2][2][4][2], const Unit& u, int wr, int wc, int fr, int fq) const {
        const int row0 = u.pm * BM + wr * 64 + fr, col0 = u.pn * BM + wc * 32 + 8 * fq;
#pragma unroll
        for (int ai = 0; ai < 2; ++ai)
#pragma unroll
            for (int m = 0; m < 4; ++m)
#pragma unroll
                for (int bj = 0; bj < 2; ++bj) { const size_t o = (size_t)(row0 + ai * HALF + m * 16) * DM + col0 + bj * HALF; const u32x4 g = *(const u32x4*)(GB + o);
                    const f32x4 g0 = {bflo(g.x), bfhi(g.x), bflo(g.y), bfhi(g.y)}, g1 = {bflo(g.z), bfhi(g.z), bflo(g.w), bfhi(g.w)};
                    *(u32x4*)(MM + o) = pack8(g0 * acc[ai][bj][m][0], g1 * acc[ai][bj][m][1]); }
    }
};
struct EpiPool {
    static constexpr bool PERM = true, HOOK = false;
    bf16_t* PM; const float* pscale; int g;
    __device__ __forceinline__ void operator()(const f32x4 (&acc)[2][2][4][2], const Unit& u, int wr, int wc, int fr, int fq) const {
        const int row0 = u.pm * BM + wr * 64 + fr, col0 = g * BM + wc * 32 + 8 * fq;
#pragma unroll
        for (int bj = 0; bj < 2; ++bj) { const f32x4 s0 = *(const f32x4*)(pscale + col0 + bj * HALF), s1 = *(const f32x4*)(pscale + col0 + bj * HALF + 4);
#pragma unroll
            for (int ai = 0; ai < 2; ++ai)
#pragma unroll
                for (int m = 0; m < 4; ++m) *(u32x4*)(PM + (size_t)(row0 + ai * HALF + m * 16) * 3072 + 2048 + col0 + bj * HALF) = pack8(acc[ai][bj][m][0] * s0, acc[ai][bj][m][1] * s1); }
    }
};

template <class Epi, class Sched, bool ALIGN_EPI>
__device__ __forceinline__ void gemm_phase(LAS unsigned char* lds, const Gemm g, const Sched& S, const Epi& E) {
    int tid = threadIdx.x; asm volatile("" : "+v"(tid));
    const int wid = __builtin_amdgcn_readfirstlane(tid >> 6), lane = tid & 63, wr = wid >> 2, wc = wid & 3, fr = lane & 15, fq = lane >> 4;
    unsigned voffA[2], voffB[2];
#pragma unroll
    for (int i = 0; i < 2; ++i) { int R, C; stage_rc(tid * 16 + i * 8192, R, C); const int Rb = Epi::PERM ? ((R & ~31) + perm32(R & 31)) : R;
        voffA[i] = (unsigned)(R * g.lda + C) * 2u; voffB[i] = (unsigned)(Rb * g.ldb + C) * 2u; }
    const size_t kstep = (size_t)(BK * 2);
    const size_t hstepA = (size_t)HALF * g.lda * 2, hstepB = (size_t)HALF * g.ldb * 2;
    const size_t tstepA = 2 * hstepA, tstepB = 2 * hstepB;
    const unsigned ldsw = (unsigned)wid * 1024u;
    const int aoff = lds_byte(wr * 64 + fr, fq * 8), boff = lds_byte(wc * 32 + fr, fq * 8);
#define PG8_SA(b, h) (((b) * 2 + (h)) * HTB)
#define PG8_SB(b, h) ((4 + (b) * 2 + (h)) * HTB)
#define PG8_STAGE(bufoff, gbase, voff) do { _Pragma("unroll") for (int _i = 0; _i < 2; ++_i) \
        __builtin_amdgcn_global_load_lds((const unsigned*)((const char*)(gbase) + (voff)[_i]), (LAS unsigned*)(lds + (bufoff) + ldsw + _i * 8192), 16, 0, 0); } while (0)
#define PG8_LDA(dst, b, h) do { _Pragma("unroll") for (int m = 0; m < 4; ++m) _Pragma("unroll") for (int k = 0; k < 2; ++k) dst[m][k] = *(const LAS bf16x8*)(lds + PG8_SA(b, h) + aoff + m * 2048 + k * 1024); } while (0)
#define PG8_LDB(dst, b, h) do { _Pragma("unroll") for (int n = 0; n < 2; ++n) _Pragma("unroll") for (int k = 0; k < 2; ++k) dst[n][k] = *(const LAS bf16x8*)(lds + PG8_SB(b, h) + boff + n * 2048 + k * 1024); } while (0)
#define PG8_MMA(ai, bj, At, Bt) do { __builtin_amdgcn_s_setprio(1); _Pragma("unroll") for (int m = 0; m < 4; ++m) _Pragma("unroll") for (int n = 0; n < 2; ++n) _Pragma("unroll") for (int k = 0; k < 2; ++k) \
        acc[ai][bj][m][n] = __builtin_amdgcn_mfma_f32_16x16x32_bf16(Bt[n][k], At[m][k], acc[ai][bj][m][n], 0, 0, 0); __builtin_amdgcn_s_setprio(0); } while (0)
#define PG8_WAIT_V(n) asm volatile("s_waitcnt vmcnt(" #n ")" ::: "memory")
#define PG8_WAIT_L(n) asm volatile("s_waitcnt lgkmcnt(" #n ")" ::: "memory")
#define PG8_BAR __builtin_amdgcn_s_barrier()
#define PG8_SCHED __builtin_amdgcn_sched_barrier(0)
    Unit cur, nxt; int ui = 0;
    if (!S.next(0, cur)) return;
    f32x4 acc[2][2][4][2];
#pragma unroll
    for (int a = 0; a < 2; ++a)
#pragma unroll
        for (int b = 0; b < 2; ++b)
#pragma unroll
            for (int m = 0; m < 4; ++m)
#pragma unroll
                for (int n = 0; n < 2; ++n) acc[a][b][m][n] = (f32x4){0.f, 0.f, 0.f, 0.f};
    bf16x8 At[4][2], B0[2][2], B1[2][2];
    const char* cA = (const char*)g.A + (size_t)cur.pm * tstepA + (size_t)cur.k0 * kstep; const char* cB = (const char*)g.Bt + (size_t)cur.pn * tstepB + (size_t)cur.k0 * kstep;
    PG8_STAGE(PG8_SB(0, 0), cB, voffB); PG8_STAGE(PG8_SB(0, 1), cB + hstepB, voffB); PG8_STAGE(PG8_SA(0, 0), cA, voffA); PG8_STAGE(PG8_SA(0, 1), cA + hstepA, voffA);
    if (wr == 1) PG8_BAR;
    PG8_WAIT_V(2); PG8_BAR;
    PG8_STAGE(PG8_SB(1, 0), cB + kstep, voffB); PG8_STAGE(PG8_SA(1, 0), cA + kstep, voffA); PG8_STAGE(PG8_SB(1, 1), cB + hstepB + kstep, voffB);
    PG8_WAIT_V(6); PG8_BAR;
    for (;;) {
        const bool has_next = S.next(ui + 1, nxt);
        const char* nA = has_next ? (const char*)g.A + (size_t)nxt.pm * tstepA + (size_t)nxt.k0 * kstep : cA; const char* nB = has_next ? (const char*)g.Bt + (size_t)nxt.pn * tstepB + (size_t)nxt.k0 * kstep : cB;
        const int nt = cur.nt;
#pragma unroll 1
        for (int t = 0; t < nt; t += 2) {
            const bool last = (t == nt - 2);
            if constexpr (Epi::HOOK) { if (t == E.hook_t) { __builtin_amdgcn_sched_barrier(0); E.hook(acc, cur, wr, wc, fr, fq); __builtin_amdgcn_sched_barrier(0); } }
            const char* a1 = cA + (size_t)(t + 1) * kstep;
            const char* a2 = last ? nA : cA + (size_t)(t + 2) * kstep; const char* b2 = last ? nB : cB + (size_t)(t + 2) * kstep;
            const char* a3 = a2 + kstep; const char* b3 = b2 + kstep;
            PG8_LDB(B0, 0, 0); PG8_LDB(B1, 0, 1); PG8_SCHED; PG8_LDA(At, 0, 0); PG8_STAGE(PG8_SA(1, 1), a1 + hstepA, voffA);
            PG8_WAIT_V(8); PG8_WAIT_L(0); PG8_BAR; PG8_MMA(0, 0, At, B0); PG8_MMA(0, 1, At, B1); PG8_BAR; PG8_SCHED;
            PG8_LDA(At, 0, 1); PG8_STAGE(PG8_SB(0, 0), b2, voffB); PG8_STAGE(PG8_SB(0, 1), b2 + hstepB, voffB); PG8_STAGE(PG8_SA(0, 0), a2, voffA);
            PG8_WAIT_V(8); PG8_WAIT_L(0); PG8_BAR; PG8_MMA(1, 0, At, B0); PG8_MMA(1, 1, At, B1); PG8_BAR; PG8_SCHED;
            PG8_LDB(B0, 1, 0); PG8_LDB(B1, 1, 1); PG8_SCHED; PG8_LDA(At, 1, 0); PG8_STAGE(PG8_SA(0, 1), a2 + hstepA, voffA);
            PG8_WAIT_V(8); PG8_WAIT_L(0); PG8_BAR; PG8_MMA(0, 0, At, B0); PG8_MMA(0, 1, At, B1); PG8_BAR; PG8_SCHED;
            PG8_LDA(At, 1, 1); PG8_STAGE(PG8_SB(1, 0), b3, voffB); PG8_STAGE(PG8_SB(1, 1), b3 + hstepB, voffB); PG8_STAGE(PG8_SA(1, 0), a3, voffA);
            PG8_WAIT_V(8); PG8_WAIT_L(0); PG8_BAR; PG8_MMA(1, 0, At, B0); PG8_MMA(1, 1, At, B1); PG8_BAR; PG8_SCHED;
        }
        if constexpr (ALIGN_EPI) { if (wr == 0) PG8_BAR; }
        E(acc, cur, wr, wc, fr, fq);
        if (!has_next) break;
#pragma unroll
        for (int a = 0; a < 2; ++a)
#pragma unroll
            for (int b = 0; b < 2; ++b)
#pragma unroll
                for (int m = 0; m < 4; ++m)
#pragma unroll
                    for (int n = 0; n < 2; ++n) acc[a][b][m][n] = (f32x4){0.f, 0.f, 0.f, 0.f};
        cur = nxt; cA = nA; cB = nB; ++ui;
        if constexpr (ALIGN_EPI) { if (wr == 1) PG8_BAR; }
    }
    PG8_WAIT_V(0);
    if constexpr (!ALIGN_EPI) { if (wr == 0) PG8_BAR; }
    PG8_BAR;
#undef PG8_SA
#undef PG8_SB
#undef PG8_STAGE
#undef PG8_LDA
#undef PG8_LDB
#undef PG8_MMA
#undef PG8_WAIT_V
#undef PG8_WAIT_L
#undef PG8_BAR
#undef PG8_SCHED
}
}


#define XB_TMO      128
#define XB_XCNT(j)  (256  + 64 * (j))
#define XB_XSUB(j)  (1280 + 64 * (j))
#define XB_XGEN(j)  (2304 + 64 * (j))
#define XB_TOP      3328
#define XB_TOPGEN   3392
#define XCD_BAR_WORDS 3456
#define XB_SPIN_CAP (1u << 18)
__device__ __forceinline__ unsigned xb_ld(unsigned* p)              { return __hip_atomic_load(p, __ATOMIC_RELAXED, __HIP_MEMORY_SCOPE_AGENT); }
__device__ __forceinline__ unsigned xb_add(unsigned* p, unsigned v) { return __hip_atomic_fetch_add(p, v, __ATOMIC_RELAXED, __HIP_MEMORY_SCOPE_AGENT); }
__device__ __forceinline__ unsigned xb_xcc_id() { return (unsigned)__builtin_amdgcn_s_getreg((3 << 11) | 20) & 0xFu; }
#define XB_SPIN(cond, bar) do { unsigned _sp = 0; while (cond) { __builtin_amdgcn_s_sleep(1); \
    if ((++_sp & 255u) == 0u) { if (xb_ld(&(bar)[XB_TMO])) break; if (_sp > XB_SPIN_CAP) { atomicAdd(&(bar)[XB_TMO], 1u); break; } } } } while (0)
struct XcdBarrier { unsigned* bar; unsigned x; volatile LAS unsigned* st; };
__device__ __forceinline__ XcdBarrier xcd_barrier_post(unsigned* bar, volatile LAS unsigned* st) {
    XcdBarrier b; b.bar = bar; b.x = xb_xcc_id(); b.st = st;
    if (threadIdx.x == 0) (void)xb_add(&bar[XB_XCNT(b.x)], 1u);
    return b;
}
__device__ __forceinline__ void xcd_barrier_complete(unsigned* bar, unsigned x, unsigned& nloc, unsigned& nx) {
    const unsigned G = gridDim.x * gridDim.y * gridDim.z;
    unsigned sum, cnt, mine, sp = 0u;
    for (;;) {
        sum = 0u; cnt = 0u; mine = 0u;
#pragma unroll
        for (unsigned j = 0; j < 16; ++j) { const unsigned c = xb_ld(&bar[XB_XCNT(j)]); sum += c; cnt += (c > 0u) ? 1u : 0u; mine = (j == x) ? c : mine; }
        if (sum == G) break;
        __builtin_amdgcn_s_sleep(1);
        if ((++sp & 255u) == 0u) { if (xb_ld(&bar[XB_TMO])) break; if (sp > XB_SPIN_CAP) { atomicAdd(&bar[XB_TMO], 1u); break; } }
    }
    nloc = mine > 0u ? mine : 1u; nx = cnt > 0u ? cnt : 1u;
}
__device__ __forceinline__ void xcd_barrier(const XcdBarrier& b) {
    asm volatile("s_waitcnt vmcnt(0)" ::: "memory");
    __syncthreads();
    if (threadIdx.x == 0) {
        unsigned* bar = b.bar;
        __builtin_amdgcn_s_waitcnt(0);
        unsigned nloc = b.st[0], nx = b.st[1];
        if (nloc == 0u) { xcd_barrier_complete(bar, b.x, nloc, nx); b.st[0] = nloc; b.st[1] = nx; }
        const unsigned old = xb_add(&bar[XB_XSUB(b.x)], 1u);
        const unsigned gen = old / nloc;
        if (old + 1u == (gen + 1u) * nloc) {
            __builtin_amdgcn_fence(__ATOMIC_RELEASE, "agent");
            asm volatile("s_waitcnt vmcnt(0)" ::: "memory");
            const unsigned og = xb_add(&bar[XB_TOP], 1u);
            const unsigned tg = og / nx;
            if (og + 1u == (tg + 1u) * nx) xb_add(&bar[XB_TOPGEN], 1u);
            else XB_SPIN(xb_ld(&bar[XB_TOPGEN]) == tg, bar);
            __builtin_amdgcn_fence(__ATOMIC_ACQUIRE, "agent");
            xb_add(&bar[XB_XGEN(b.x)], 1u);
            asm volatile("s_waitcnt vmcnt(0)" ::: "memory");
        } else {
            XB_SPIN(xb_ld(&bar[XB_XGEN(b.x)]) == gen, bar);
            __builtin_amdgcn_fence(__ATOMIC_ACQUIRE, "agent");
            asm volatile("s_waitcnt vmcnt(0)" ::: "memory");
        }
    }
    __syncthreads();
}
struct Args { const float* in[21]; float* out; unsigned char* ws; int pad0, pad1; };
#define LDS_WAIT() asm volatile("s_waitcnt lgkmcnt(0)" ::: "memory")
#define GRID_SYNC() xcd_barrier(xbar)

__device__ __forceinline__ int dest_row(int mode, int n) {
    if (mode == 1) { const int half = n >= DFF ? 1 : 0; const int j = n - half * DFF; return ((j >> 7) << 8) + (half << 7) + (j & 127); }
    if (mode == 2) { if (n < 1024 || (n >= 3072 && n < 4096)) { const int d = n & 127, half = d >> 6, dd = d & 63, i = dd & 31, nb = dd >> 5, rho = 32 * half + i;
            return (n & ~127) + 32 * (rho >> 4) + 8 * ((rho >> 2) & 3) + 4 * nb + (rho & 3); } return n; }
    if (mode == 3) { const int half = n >= DM ? 1 : 0; const int j = n - half * DM; return ((j >> 7) << 8) + (half << 7) + (j & 127); }
    return n;
}
__device__ __forceinline__ void tr_item(const float* W, int K, int N, bf16_t* WT, int row_off, int mode, LAS float* scr, int item, int lane, int ldk = 0, int koff = 0) {
    if (ldk == 0) ldk = K;
    const int nblk = N >> 6, kb = item / nblk, nb = item - kb * nblk, k0 = kb << 6, n0 = nb << 6;
    f32x4 v[16];
#pragma unroll
    for (int i = 0; i < 16; ++i) { const int idx = i * 64 + lane, kk = idx >> 4, c4 = idx & 15; v[i] = *(const f32x4*)(W + (size_t)(k0 + kk) * N + n0 + 4 * c4); }
#pragma unroll
    for (int i = 0; i < 16; ++i) { const int idx = i * 64 + lane, kk = idx >> 4, c4 = idx & 15; LAS float* s = scr + kk * 65 + 4 * c4; s[0] = v[i][0]; s[1] = v[i][1]; s[2] = v[i][2]; s[3] = v[i][3]; }
    LDS_WAIT(); asm volatile("" ::: "memory");
    const int c = lane & 7;
#pragma unroll
    for (int j = 0; j < 8; ++j) { const int n = (lane >> 3) + 8 * j; const LAS float* s = scr + (8 * c) * 65 + n;
        u32x4 o; o.x = pk2(s[0], s[65]); o.y = pk2(s[2 * 65], s[3 * 65]); o.z = pk2(s[4 * 65], s[5 * 65]); o.w = pk2(s[6 * 65], s[7 * 65]);
        *(u32x4*)(WT + (size_t)(row_off + dest_row(mode, n0 + n)) * ldk + koff + k0 + 8 * c) = o; }
    LDS_WAIT(); asm volatile("" ::: "memory");
}

__device__ __forceinline__ void norm_rows(const float* src_lat, const float* src_ctx, int nrows, const float* gvec, const float* mod, int shidx, int scidx, bf16_t* dst, int gw, int NGW, int lane, const float* part = nullptr, int npart = 0) {
    for (int r0 = gw; r0 < nrows; r0 += 2 * NGW) {
        const int r1 = r0 + NGW; const bool has1 = r1 < nrows; const int r1c = has1 ? r1 : r0;
        const float* srcA = r0 < NLAT ? src_lat + (size_t)r0 * DM : src_ctx + (size_t)(r0 - NLAT) * DM;
        const float* srcB = r1c < NLAT ? src_lat + (size_t)r1c * DM : src_ctx + (size_t)(r1c - NLAT) * DM;
        const f32x4* a4 = (const f32x4*)srcA + lane; const f32x4* b4 = (const f32x4*)srcB + lane;
        f32x4 va[8], vb[8];
#pragma unroll
        for (int j = 0; j < 8; ++j) { va[j] = a4[64 * j]; vb[j] = b4[64 * j]; }
        if (npart > 0) {
            if (r0 >= NLAT) { const f32x4* p4 = (const f32x4*)(part + (size_t)(r0 - NLAT) * DM) + lane;
                for (int p = 0; p < npart; ++p) {
#pragma unroll
                    for (int j = 0; j < 8; ++j) va[j] += p4[(size_t)p * (NCTX * DM / 4) + 64 * j]; } }
            if (r1c >= NLAT) { const f32x4* p4 = (const f32x4*)(part + (size_t)(r1c - NLAT) * DM) + lane;
                for (int p = 0; p < npart; ++p) {
#pragma unroll
                    for (int j = 0; j < 8; ++j) vb[j] += p4[(size_t)p * (NCTX * DM / 4) + 64 * j]; } }
        }
        float sa = 0.f, sb = 0.f;
#pragma unroll
        for (int j = 0; j < 8; ++j) { sa += (va[j][0] * va[j][0] + va[j][1] * va[j][1]) + (va[j][2] * va[j][2] + va[j][3] * va[j][3]); sb += (vb[j][0] * vb[j][0] + vb[j][1] * vb[j][1]) + (vb[j][2] * vb[j][2] + vb[j][3] * vb[j][3]); }
#pragma unroll
        for (int o = 1; o < 64; o <<= 1) { sa += __shfl_xor(sa, o); sb += __shfl_xor(sb, o); }
        const float rsa = 1.0f / sqrtf(sa * (1.0f / DM) + 1e-6f), rsb = 1.0f / sqrtf(sb * (1.0f / DM) + 1e-6f);
        const int bsA = r0 < SEQ ? 0 : (r0 < NLAT ? 1 : 2), bsB = r1c < SEQ ? 0 : (r1c < NLAT ? 1 : 2);
        const f32x4* g4 = (const f32x4*)gvec + lane;
        const f32x4* scA = (const f32x4*)(mod + bsA * NMOD + scidx * DM) + lane; const f32x4* shA = (const f32x4*)(mod + bsA * NMOD + shidx * DM) + lane;
        const f32x4* scB = (const f32x4*)(mod + bsB * NMOD + scidx * DM) + lane; const f32x4* shB = (const f32x4*)(mod + bsB * NMOD + shidx * DM) + lane;
        u32x2* oA = (u32x2*)(dst + (size_t)r0 * DM) + lane; u32x2* oB = (u32x2*)(dst + (size_t)r1c * DM) + lane;
#pragma unroll
        for (int j = 0; j < 8; ++j) { const f32x4 gg = g4[64 * j];
            const f32x4 ya = va[j] * rsa * gg, oa = ya * (scA[64 * j] + 1.0f) + shA[64 * j]; u32x2 w; w.x = pk2(oa[0], oa[1]); w.y = pk2(oa[2], oa[3]); oA[64 * j] = w;
            if (has1) { const f32x4 yb = vb[j] * rsb * gg, ob = yb * (scB[64 * j] + 1.0f) + shB[64 * j]; u32x2 w2; w2.x = pk2(ob[0], ob[1]); w2.y = pk2(ob[2], ob[3]); oB[64 * j] = w2; } }
    }
}

__device__ __forceinline__ s16x4 lds_tr(const LAS unsigned char* p) { return __builtin_amdgcn_ds_read_tr16_b64_v4i16((LAS s16x4*)p); }
__device__ __forceinline__ bf16x8 lds_tr8(const LAS unsigned char* base, int pitch, int k0, int n0, int lane) {
    const int g = lane >> 4, q = (lane & 15) >> 2, p = lane & 3;
    const LAS unsigned char* a = base + (k0 + 8 * g + q) * pitch + (n0 + 4 * p) * 2;
    const s16x4 lo = lds_tr(a), hi = lds_tr(a + 4 * pitch);
    return (bf16x8){lo[0], lo[1], lo[2], lo[3], hi[0], hi[1], hi[2], hi[3]};
}
__device__ __forceinline__ float log2_gamma(const float* decay_logit, int dir, int h) { const float x = decay_logit[dir * 8 + h]; return -log1pf(expf(-x)) * LOG2E; }
__device__ __forceinline__ int slot_row0(int b, int slot) { return slot < 2 ? NLAT + b * CTXL + slot * 128 : b * SEQ + (slot - 2) * 128; }

__device__ __forceinline__ void r1_task(LAS unsigned char* lds, int task, const bf16_t* Kg, const bf16_t* Vg, bf16_t* KVS, const float* decay_logit) {
    int tid = threadIdx.x; asm volatile("" : "+v"(tid));
    const int lane = tid & 63, w = tid >> 6, g = lane >> 4, r16 = lane & 15;
    const int bh = task / NSLOT, slot = task - bh * NSLOT, b = bh >> 3, h = bh & 7, row0 = slot_row0(b, slot);
    const float l2f = log2_gamma(decay_logit, 0, h), l2b = log2_gamma(decay_logit, 1, h);
    LAS unsigned char* VS = lds; LAS unsigned char* KF = lds + 67584; LAS unsigned char* KB = lds + 67584 + 34816;
#pragma unroll
    for (int it = 0; it < 8; ++it) { const int p = tid + it * 512, r = p >> 5, cc = p & 31; *(LAS u32x4*)(VS + r * 528 + cc * 16) = *(const u32x4*)(Vg + (size_t)(row0 + r) * DM + h * 256 + cc * 8); }
#pragma unroll
    for (int it = 0; it < 4; ++it) { const int p = tid + it * 512, r = p >> 4, cc = p & 15; const u32x4 kv = *(const u32x4*)(Kg + (size_t)(row0 + r) * 1024 + h * 128 + cc * 8);
        const float wf = __builtin_amdgcn_exp2f(l2f * (float)(127 - r)), wb = __builtin_amdgcn_exp2f(l2b * (float)r);
        u32x4 of, ob;
        of.x = pk2(bflo(kv.x) * wf, bfhi(kv.x) * wf); of.y = pk2(bflo(kv.y) * wf, bfhi(kv.y) * wf); of.z = pk2(bflo(kv.z) * wf, bfhi(kv.z) * wf); of.w = pk2(bflo(kv.w) * wf, bfhi(kv.w) * wf);
        ob.x = pk2(bflo(kv.x) * wb, bfhi(kv.x) * wb); ob.y = pk2(bflo(kv.y) * wb, bfhi(kv.y) * wb); ob.z = pk2(bflo(kv.z) * wb, bfhi(kv.z) * wb); ob.w = pk2(bflo(kv.w) * wb, bfhi(kv.w) * wb);
        *(LAS u32x4*)(KF + r * 272 + cc * 16) = of; *(LAS u32x4*)(KB + r * 272 + cc * 16) = ob; }
    __syncthreads();
#pragma unroll 1
    for (int dir = 0; dir < 2; ++dir) {
        const LAS unsigned char* KW = dir == 0 ? KF : KB;
        f32x4 af[8][2];
#pragma unroll
        for (int mb = 0; mb < 8; ++mb)
#pragma unroll
            for (int nb = 0; nb < 2; ++nb) af[mb][nb] = (f32x4){0.f, 0.f, 0.f, 0.f};
#pragma unroll
        for (int ks = 0; ks < 4; ++ks) {
            bf16x8 bv[2];
#pragma unroll
            for (int nb = 0; nb < 2; ++nb) bv[nb] = lds_tr8(VS, 528, 32 * ks, 32 * w + 16 * nb, lane);
#pragma unroll
            for (int mb = 0; mb < 8; ++mb) { const bf16x8 kf = lds_tr8(KW, 272, 32 * ks, 16 * mb, lane);
#pragma unroll
                for (int nb = 0; nb < 2; ++nb) af[mb][nb] = __builtin_amdgcn_mfma_f32_16x16x32_bf16(kf, bv[nb], af[mb][nb], 0, 0, 0); }
            __builtin_amdgcn_sched_barrier(0);
        }
        bf16_t* of_ = KVS + ((size_t)(bh * NSLOT + slot) * 2 + dir) * 32768;
#pragma unroll
        for (int mb = 0; mb < 8; ++mb)
#pragma unroll
            for (int nb = 0; nb < 2; ++nb) { const int e = 32 * w + 16 * nb + r16, d = 16 * mb + 4 * g; u32x2 o;
                o.x = pk2(af[mb][nb][0], af[mb][nb][1]); o.y = pk2(af[mb][nb][2], af[mb][nb][3]); *(u32x2*)(of_ + e * 128 + d) = o; }
    }
    __syncthreads();
}

__device__ __forceinline__ void r3_task(LAS unsigned char* lds, int task, const bf16_t* Qg, const bf16_t* Kg, const bf16_t* Vg, const bf16_t* KVS, const bf16_t* Gs, bf16_t* ZA, const float* decay_logit) {
    int tid = threadIdx.x; asm volatile("" : "+v"(tid));
    const int lane = tid & 63, w = tid >> 6, g = lane >> 4, r16 = lane & 15;
    const int bh = task >> 5, c = task & 31, b = bh >> 3, h = bh & 7, row0 = b * SEQ + c * 128;
    const float l2f = log2_gamma(decay_logit, 0, h), l2b = log2_gamma(decay_logit, 1, h);
    LAS unsigned char* QS = lds; LAS unsigned char* KS = lds + 34816; LAS unsigned char* CS = lds + 69632;
#pragma unroll
    for (int it = 0; it < 4; ++it) { const int p = tid + it * 512, r = p >> 4, cc = p & 15;
        *(LAS u32x4*)(QS + r * 272 + cc * 16) = *(const u32x4*)(Qg + (size_t)(row0 + r) * 1024 + h * 128 + cc * 8);
        *(LAS u32x4*)(KS + r * 272 + cc * 16) = *(const u32x4*)(Kg + (size_t)(row0 + r) * 1024 + h * 128 + cc * 8); }
#pragma unroll
    for (int it = 0; it < 8; ++it) { const int p = tid + it * 512, r = p >> 5, cc = p & 31; *(LAS u32x4*)(CS + r * 528 + cc * 16) = *(const u32x4*)(Vg + (size_t)(row0 + r) * DM + h * 256 + cc * 8); }
    __syncthreads();
    f32x4 pa[8];
#pragma unroll
    for (int mb = 0; mb < 8; ++mb) pa[mb] = (f32x4){0.f, 0.f, 0.f, 0.f};
    bf16x8 qf[4];
#pragma unroll
    for (int ks = 0; ks < 4; ++ks) qf[ks] = *(const LAS bf16x8*)(QS + (16 * w + r16) * 272 + (32 * ks + 8 * g) * 2);
#pragma unroll
    for (int ks = 0; ks < 4; ++ks)
#pragma unroll
        for (int mb = 0; mb < 8; ++mb) { const bf16x8 kf = *(const LAS bf16x8*)(KS + (16 * mb + r16) * 272 + (32 * ks + 8 * g) * 2); pa[mb] = __builtin_amdgcn_mfma_f32_16x16x32_bf16(kf, qf[ks], pa[mb], 0, 0, 0); }
    {   const int i = 16 * w + r16;
#pragma unroll
        for (int mb = 0; mb < 8; ++mb)
#pragma unroll
            for (int jj = 0; jj < 4; ++jj) { const int j = 16 * mb + 4 * g + jj; const int dd = i - j;
                const float f = dd > 0 ? __builtin_amdgcn_exp2f(l2f * (float)dd) : (dd < 0 ? __builtin_amdgcn_exp2f(l2b * (float)(-dd)) : 2.0f); pa[mb][jj] *= f; }
    }
    __syncthreads();
#pragma unroll
    for (int mb = 0; mb < 8; ++mb) { u32x2 o; o.x = pk2(pa[mb][0], pa[mb][1]); o.y = pk2(pa[mb][2], pa[mb][3]); *(LAS u32x2*)(KS + (16 * w + r16) * 272 + (16 * mb + 4 * g) * 2) = o; }
    LDS_WAIT(); asm volatile("" ::: "memory");
    f32x4 acc[16];
#pragma unroll
    for (int nb = 0; nb < 16; ++nb) acc[nb] = (f32x4){0.f, 0.f, 0.f, 0.f};
#pragma unroll
    for (int ks = 0; ks < 4; ++ks) { const bf16x8 pf = *(const LAS bf16x8*)(KS + (16 * w + r16) * 272 + (32 * ks + 8 * g) * 2);
#pragma unroll
        for (int nb = 0; nb < 16; ++nb) { const bf16x8 vf = lds_tr8(CS, 528, 32 * ks, 16 * nb, lane); acc[nb] = __builtin_amdgcn_mfma_f32_16x16x32_bf16(pf, vf, acc[nb], 0, 0, 0); if ((nb & 3) == 3) __builtin_amdgcn_sched_barrier(0); } }
#pragma unroll 1
    for (int dir = 0; dir < 2; ++dir) {
        __syncthreads();
        const bf16_t* Sg = KVS + ((size_t)(bh * NSLOT + c + 2) * 2 + dir) * 32768;
#pragma unroll
        for (int it = 0; it < 8; ++it) { const int p = tid + it * 512, r = p >> 4, cc = p & 15; *(LAS u32x4*)(CS + r * 272 + cc * 16) = *(const u32x4*)(Sg + (size_t)r * 128 + cc * 8); }
        __syncthreads();
        const int ia = 16 * w + r16; const float sf = dir == 0 ? __builtin_amdgcn_exp2f(l2f * (float)(ia + 1)) : __builtin_amdgcn_exp2f(l2b * (float)(128 - ia));
#pragma unroll
        for (int ks = 0; ks < 4; ++ks) { bf16x8 qs; const bf16x8 q0 = *(const LAS bf16x8*)(QS + (16 * w + r16) * 272 + (32 * ks + 8 * g) * 2);
#pragma unroll
            for (int e = 0; e < 8; e += 2) { const unsigned pk = pk2(bf1(q0[e]) * sf, bf1(q0[e + 1]) * sf); qs[e] = (short)(pk & 0xffffu); qs[e + 1] = (short)(pk >> 16); }
#pragma unroll
            for (int nb = 0; nb < 16; ++nb) { const bf16x8 sfr = *(const LAS bf16x8*)(CS + (16 * nb + r16) * 272 + (32 * ks + 8 * g) * 2); acc[nb] = __builtin_amdgcn_mfma_f32_16x16x32_bf16(qs, sfr, acc[nb], 0, 0, 0); if ((nb & 3) == 3) __builtin_amdgcn_sched_barrier(0); } }
    }
#pragma unroll
    for (int jj = 0; jj < 4; ++jj) {
        float s = 0.f;
#pragma unroll
        for (int nb = 0; nb < 16; ++nb) s += acc[nb][jj];
        s += __shfl_xor(s, 1); s += __shfl_xor(s, 2); s += __shfl_xor(s, 4); s += __shfl_xor(s, 8);
        const float mu = s * (1.0f / 256.0f); float q = 0.f;
#pragma unroll
        for (int nb = 0; nb < 16; ++nb) { const float d = acc[nb][jj] - mu; q += d * d; }
        q += __shfl_xor(q, 1); q += __shfl_xor(q, 2); q += __shfl_xor(q, 4); q += __shfl_xor(q, 8);
        const float rstd = 1.0f / sqrtf(q * (1.0f / 256.0f) + 1e-5f);
        const size_t ro = (size_t)(row0 + 16 * w + 4 * g + jj) * DM + h * 256 + r16, zo = (size_t)(row0 + 16 * w + 4 * g + jj) * 3072 + h * 256 + r16;
#pragma unroll
        for (int nb = 0; nb < 16; ++nb) { const float gs = __builtin_bit_cast(float, ((unsigned)Gs[ro + 16 * nb]) << 16); ZA[zo + 16 * nb] = (bf16_t)f2bf(gs * (acc[nb][jj] - mu) * rstd); }
    }
    __syncthreads();
}

__global__ void __launch_bounds__(512, 2) fwd_megakernel(Args args) {
    extern __shared__ __attribute__((aligned(16))) unsigned char lds_raw[];
    LAS unsigned char* lds = (LAS unsigned char*)lds_raw;
    cg::grid_group grid = cg::this_grid();
    const int tid = threadIdx.x, lane = tid & 63, wave = __builtin_amdgcn_readfirstlane(tid >> 6);
    const int G = gridDim.x, bx = blockIdx.x;
    const int gw = bx * 8 + wave, NGW = G * 8;
    unsigned char* ws = args.ws;
    const float* x = args.in[0]; const float* cvec = args.in[1]; const float* ctx = args.in[2]; const float* cctx = args.in[3];
    const float* w_ada = args.in[4]; const float* b_ada = args.in[5]; const float* norm_g = args.in[6];
    const float* decay_logit = args.in[12]; const float* pool_scale = args.in[14]; const float* b_gate = args.in[18]; const float* final_g = args.in[20];
    float* out = args.out;
    float* MOD = (float*)(ws + WS_MOD); float* ROPE = (float*)(ws + WS_ROPE);
    bf16_t* W13A = (bf16_t*)(ws + WS_W13A); bf16_t* W2A = (bf16_t*)(ws + WS_W2A); bf16_t* W13B = (bf16_t*)(ws + WS_W13B); bf16_t* W2B = (bf16_t*)(ws + WS_W2B);
    bf16_t* WIN = (bf16_t*)(ws + WS_WIN); bf16_t* WOA = (bf16_t*)(ws + WS_WOA); bf16_t* WOB = (bf16_t*)(ws + WS_WOB); bf16_t* WOUT = (bf16_t*)(ws + WS_WOUT); bf16_t* POOLW = (bf16_t*)(ws + WS_POOLW);
    bf16_t* AN = (bf16_t*)(ws + WS_AN); bf16_t* H = (bf16_t*)(ws + WS_H); float* HC1 = (float*)(ws + WS_HC1);
    bf16_t* Kb = (bf16_t*)(ws + WS_K); bf16_t* Qb = (bf16_t*)(ws + WS_Q); bf16_t* Vb = (bf16_t*)(ws + WS_V); bf16_t* Gb = (bf16_t*)(ws + WS_G); bf16_t* PIN = (bf16_t*)(ws + WS_PIN);
    bf16_t* GA = (bf16_t*)(ws + WS_GA); bf16_t* GB = (bf16_t*)(ws + WS_GB); bf16_t* POOLED = (bf16_t*)(ws + WS_POOLED); bf16_t* PM = (bf16_t*)(ws + WS_PM);
    bf16_t* KVS = (bf16_t*)(ws + WS_H + 26 * MiB); bf16_t* ZA = AN; bf16_t* MMb = Gb;

#ifdef PROBE_A
    unsigned long long t_probe0 = 0, t_probe1 = 0;
#define PSTAMP(k, var) do { if ((k) == PROBE_A) var = __builtin_amdgcn_s_memrealtime(); } while (0)
#define PSTAMP2(k, var) do { if ((k) == PROBE_B) var = __builtin_amdgcn_s_memrealtime(); } while (0)
#else
#define PSTAMP(k, var) do {} while (0)
#define PSTAMP2(k, var) do {} while (0)
#endif
    volatile LAS unsigned* xst = (volatile LAS unsigned*)(lds + LDS_BYTES - 64);
    if (tid < 2) xst[tid] = 0u;
    __syncthreads();
    const XcdBarrier xbar = xcd_barrier_post((unsigned*)(ws + WS_BAR), xst);
    if (args.pad0 == 0x5a5a5a5a) grid.sync();
    PSTAMP(0, t_probe0); PSTAMP2(0, t_probe1);
    {
        LAS float* scr = (LAS float*)(lds + wave * 16640);
        constexpr int I_13 = 32 * 176, I_2 = 88 * 32, I_IN = 32 * 112, I_GT = 32 * 64, I_OA = 32 * 32, I_OB = 16 * 32, I_OUT = 32 * 32, I_PW = 16;
        constexpr int NIT = 2 * I_13 + 2 * I_2 + I_IN + I_GT + I_OA + I_OB + I_OUT + 4 * I_PW;
        for (int it = gw; it < NIT; it += NGW) {
            int r = it;
            if (r < I_13) { tr_item(args.in[7], DM, 2 * DFF, W13A, 0, 1, scr, r, lane); continue; } r -= I_13;
            if (r < I_13) { tr_item(args.in[9], DM, 2 * DFF, W13B, 0, 1, scr, r, lane); continue; } r -= I_13;
            if (r < I_2) { tr_item(args.in[8], DFF, DM, W2A, 0, 0, scr, r, lane); continue; } r -= I_2;
            if (r < I_2) { tr_item(args.in[10], DFF, DM, W2B, 0, 0, scr, r, lane); continue; } r -= I_2;
            if (r < I_IN) { tr_item(args.in[11], DM, 7168, WIN, 0, 2, scr, r, lane); continue; } r -= I_IN;
            if (r < I_GT) { tr_item(args.in[17], DM, 4096, WIN, 7168, 3, scr, r, lane); continue; } r -= I_GT;
            if (r < I_OA) { tr_item(args.in[15], DM, DM, WOA, 0, 0, scr, r, lane, 3072, 0); continue; } r -= I_OA;
            if (r < I_OB) { tr_item(args.in[16], 1024, DM, WOA, 0, 0, scr, r, lane, 3072, 2048); continue; } r -= I_OB;
            if (r < I_OUT) { tr_item(args.in[19], DM, DM, WOUT, 0, 0, scr, r, lane); continue; } r -= I_OUT;
            { const int gp = r >> 4; tr_item(args.in[13] + (size_t)gp * 65536, 256, 256, POOLW + (size_t)gp * 65536, 0, 0, scr, r & 15, lane); }
        }
        for (int it = gw; it < 72 * 32; it += NGW) {
            const int cgp = it % 72, kc = it / 72, col = cgp * 256 + lane * 4, k = kc * 64 + lane;
            const float s0 = fsilu(cvec[k]), s1 = fsilu(cvec[DM + k]), s2 = fsilu(cctx[k]);
            f32x4 a0 = {0.f, 0.f, 0.f, 0.f}, a1 = a0, a2 = a0;
#pragma unroll 16
            for (int kk = 0; kk < 64; ++kk) { const f32x4 wv = *(const f32x4*)(w_ada + (size_t)(kc * 64 + kk) * NMOD + col);
                a0 += wv * __shfl(s0, kk); a1 += wv * __shfl(s1, kk); a2 += wv * __shfl(s2, kk); }
            if (kc == 0) { const f32x4 bv = *(const f32x4*)(b_ada + col); a0 += bv; a1 += bv; a2 += bv; }
#pragma unroll
            for (int e = 0; e < 4; ++e) { __hip_atomic_fetch_add(MOD + col + e, a0[e], __ATOMIC_RELAXED, __HIP_MEMORY_SCOPE_AGENT); __hip_atomic_fetch_add(MOD + NMOD + col + e, a1[e], __ATOMIC_RELAXED, __HIP_MEMORY_SCOPE_AGENT);
                __hip_atomic_fetch_add(MOD + 2 * NMOD + col + e, a2[e], __ATOMIC_RELAXED, __HIP_MEMORY_SCOPE_AGENT); }
        }
        { const int id = bx * 512 + tid; if (id < 2048) { const int pos = id >> 5, i = id & 31; const float inv = powf(10000.0f, -(float)i * (1.0f / 32.0f)); const float ang = (float)pos * inv; ROPE[2 * id] = cosf(ang); ROPE[2 * id + 1] = sinf(ang); } }
    }
    GRID_SYNC();
#if defined(STOP) && STOP == 100
    for (size_t i = (size_t)bx * 512 + tid; i < (size_t)NLAT * DM; i += (size_t)G * 512) out[i] = bf1((short)WIN[i]) + (i + (size_t)NLAT * DM < (size_t)11264 * 2048 ? bf1((short)WIN[i + (size_t)NLAT * DM]) : 0.f);
    return;
#endif
    PSTAMP(1, t_probe0); PSTAMP2(1, t_probe1);
    norm_rows(x, ctx, MT, norm_g, MOD, 0, 1, AN, gw, NGW, lane);
    GRID_SYNC();
    PSTAMP(2, t_probe0); PSTAMP2(2, t_probe1);
    { pg8::Gemm g{AN, W13A, DM, DM}; pg8::MixOrder S; S.init(32, 44, 2, 44, G, bx, 32); pg8::EpiSwiglu E{H, DFF}; pg8::gemm_phase<pg8::EpiSwiglu, pg8::MixOrder, true>(lds, g, S, E); }
    GRID_SYNC();
    PSTAMP(3, t_probe0); PSTAMP2(3, t_probe1);
    { pg8::Gemm g{H, W2A, DFF, DFF}; pg8::MixOrder S; S.init(32, 8, 2, 8, G, bx, 88, 11); pg8::EpiResid E{x, out, (float*)(ws + WS_K), MOD, 2, 0.5f}; pg8::gemm_phase<pg8::EpiResid, pg8::MixOrder, true>(lds, g, S, E); }
    GRID_SYNC();
#if defined(STOP) && STOP == 3
    return;
#endif
    PSTAMP(4, t_probe0); PSTAMP2(4, t_probe1);
    norm_rows(out, ctx, MT, norm_g + DM, MOD, 3, 4, AN, gw, NGW, lane, (const float*)(ws + WS_K), 11);
    GRID_SYNC();
#if defined(STOP) && STOP == 4
    for (size_t i = (size_t)bx * 512 + tid; i < (size_t)NLAT * DM; i += (size_t)G * 512) out[i] = bf1((short)AN[i]) + ((i >> 11) < 512 ? bf1((short)AN[i + (size_t)NLAT * DM]) : 0.f);
    return;
#endif
    PSTAMP(5, t_probe0); PSTAMP2(5, t_probe1);
    { pg8::Gemm g{AN, WIN, DM, DM}; pg8::MixOrder S; S.init(32, 44, 2, 12, G, bx, 32); pg8::EpiIn E{Kb, Qb, Vb, Gb, PIN, GA, GB, b_gate, ROPE}; pg8::gemm_phase<pg8::EpiIn, pg8::MixOrder, true>(lds, g, S, E); }
    GRID_SYNC();
#if defined(STOP) && STOP == 5
    for (size_t i = (size_t)bx * 512 + tid; i < (size_t)NLAT * DM; i += (size_t)G * 512) { const size_t r = i >> 11, c = i & 2047; out[i] = bf1((short)Kb[r * 1024 + (c & 1023)]) + bf1((short)Qb[r * 1024 + (c & 1023)]) + bf1((short)Vb[i]) + bf1((short)Gb[i]) + bf1((short)PIN[r * 1024 + (c & 1023)]) + bf1((short)GA[i]) + bf1((short)GB[i]); }
    return;
#endif
    PSTAMP(6, t_probe0); PSTAMP2(6, t_probe1);
    for (int t = bx; t < 16 * NSLOT; t += G) r1_task(lds, t, Kb, Vb, KVS, decay_logit);
    for (int it = bx * 512 + tid; it < NLAT * 128; it += G * 512) {
        const int r = it >> 7, pc = it & 127, gp = pc >> 5, win = 2 << gp, lo = win >> 1, hi = win - 1 - lo, t = r & (SEQ - 1), rb = r - t;
        const int st = t - lo < 0 ? 0 : t - lo, en = t + hi + 1 > SEQ ? SEQ : t + hi + 1;
        float s[8] = {0.f, 0.f, 0.f, 0.f, 0.f, 0.f, 0.f, 0.f};
        for (int q = st; q < en; ++q) { const u32x4 v = *(const u32x4*)(PIN + (size_t)(rb + q) * 1024 + pc * 8);
            s[0] += bflo(v.x); s[1] += bfhi(v.x); s[2] += bflo(v.y); s[3] += bfhi(v.y); s[4] += bflo(v.z); s[5] += bfhi(v.z); s[6] += bflo(v.w); s[7] += bfhi(v.w); }
        const float ic = 1.0f / (float)(en - st); const u32x4 v = *(const u32x4*)(PIN + (size_t)r * 1024 + pc * 8);
        u32x4 o; o.x = pk2(s[0] * ic - bflo(v.x), s[1] * ic - bfhi(v.x)); o.y = pk2(s[2] * ic - bflo(v.y), s[3] * ic - bfhi(v.y)); o.z = pk2(s[4] * ic - bflo(v.z), s[5] * ic - bfhi(v.z)); o.w = pk2(s[6] * ic - bflo(v.w), s[7] * ic - bfhi(v.w));
        *(u32x4*)(POOLED + (size_t)r * 1024 + pc * 8) = o;
    }
    GRID_SYNC();
    PSTAMP(7, t_probe0); PSTAMP2(7, t_probe1);
    for (int id = bx * 512 + tid; id < 16 * 2 * 4096; id += G * 512) {
        const int bh = id >> 13, dir = (id >> 12) & 1, off = (id & 4095) * 8, h = bh & 7;
        const float cd = __builtin_amdgcn_exp2f(log2_gamma(decay_logit, dir, h) * 128.0f);
        bf16_t* base = KVS + (size_t)bh * NSLOT * 65536 + dir * 32768 + off;
        float r[8] = {0.f, 0.f, 0.f, 0.f, 0.f, 0.f, 0.f, 0.f};
#pragma unroll 2
        for (int s = 0; s < NSLOT; ++s) {
            const int slot = dir == 0 ? s : (s == 0 ? 1 : (s == 1 ? 0 : NSLOT + 1 - s));
            u32x4* p = (u32x4*)(base + (size_t)slot * 65536); const u32x4 v = *p;
            u32x4 o; o.x = pk2(r[0], r[1]); o.y = pk2(r[2], r[3]); o.z = pk2(r[4], r[5]); o.w = pk2(r[6], r[7]); *p = o;
            r[0] = r[0] * cd + bflo(v.x); r[1] = r[1] * cd + bfhi(v.x); r[2] = r[2] * cd + bflo(v.y); r[3] = r[3] * cd + bfhi(v.y);
            r[4] = r[4] * cd + bflo(v.z); r[5] = r[5] * cd + bfhi(v.z); r[6] = r[6] * cd + bflo(v.w); r[7] = r[7] * cd + bfhi(v.w);
        }
    }
    { const int gp = (bx >> 5) & 3; pg8::Gemm g{POOLED + gp * 256, POOLW + (size_t)gp * 65536, 1024, 256}; pg8::MixOrder S; S.init(32, 1, 0, 1, 1 << 20, bx < 128 ? (bx & 31) : 32, 4);
        pg8::EpiPool E{ZA, pool_scale, gp}; pg8::gemm_phase<pg8::EpiPool, pg8::MixOrder, true>(lds, g, S, E); }
    GRID_SYNC();
#if defined(STOP) && STOP == 7
    for (size_t i = (size_t)bx * 512 + tid; i < (size_t)NLAT * DM; i += (size_t)G * 512) { const size_t r = i >> 11, c = i & 2047; out[i] = bf1((short)POOLED[r * 1024 + (c & 1023)]) + 0.f + bf1((short)KVS[i]) + bf1((short)KVS[i + (size_t)NLAT * DM]); }
    return;
#endif
    PSTAMP(8, t_probe0); PSTAMP2(8, t_probe1);
    for (int t = bx; t < 512; t += G) r3_task(lds, t, Qb, Kb, Vb, KVS, Gb, ZA, decay_logit);
    GRID_SYNC();
#if defined(STOP) && STOP == 8
    for (size_t i = (size_t)bx * 512 + tid; i < (size_t)NLAT * DM; i += (size_t)G * 512) out[i] = bf1((short)ZA[i]);
    return;
#endif
    PSTAMP(9, t_probe0); PSTAMP2(9, t_probe1);
    { pg8::Gemm g{ZA, WOA, 3072, 3072}; pg8::MixOrder S; S.init(32, 8, 0, 1, G, bx, 48); pg8::EpiMerge E{GA, GB, MMb, 32}; pg8::gemm_phase<pg8::EpiMerge, pg8::MixOrder, true>(lds, g, S, E); }
    GRID_SYNC();
#if defined(STOP) && STOP == 9
    for (size_t i = (size_t)bx * 512 + tid; i < (size_t)NLAT * DM; i += (size_t)G * 512) out[i] = bf1((short)MMb[i]);
    return;
#endif
    PSTAMP(10, t_probe0); PSTAMP2(10, t_probe1);
    { pg8::Gemm g{MMb, WOUT, DM, DM}; pg8::MixOrder S; S.init(32, 8, 0, 1, G, bx, 32); pg8::EpiResid E{out, out, out, MOD, 5, 1.0f}; pg8::gemm_phase<pg8::EpiResid, pg8::MixOrder, true>(lds, g, S, E); }
    GRID_SYNC();
    PSTAMP(11, t_probe0); PSTAMP2(11, t_probe1);
    norm_rows(out, out, NLAT, norm_g + 2 * DM, MOD, 6, 7, AN, gw, NGW, lane);
    GRID_SYNC();
    PSTAMP(12, t_probe0); PSTAMP2(12, t_probe1);
    { pg8::Gemm g{AN, W13B, DM, DM}; pg8::MixOrder S; S.init(32, 44, 0, 1, G, bx, 32); pg8::EpiSwiglu E{H, DFF}; pg8::gemm_phase<pg8::EpiSwiglu, pg8::MixOrder, true>(lds, g, S, E); }
    GRID_SYNC();
    PSTAMP(13, t_probe0); PSTAMP2(13, t_probe1);
    { pg8::Gemm g{H, W2B, DFF, DFF}; pg8::MixOrder S; S.init(32, 8, 0, 1, G, bx, 88); pg8::EpiResid E{out, out, out, MOD, 8, 0.5f}; pg8::gemm_phase<pg8::EpiResid, pg8::MixOrder, true>(lds, g, S, E); }
    GRID_SYNC();
    PSTAMP(14, t_probe0); PSTAMP2(14, t_probe1);
    for (int r = gw; r < NLAT; r += 2 * NGW) {
        f32x4* a4 = (f32x4*)(out + (size_t)r * DM) + lane; f32x4* b4 = (f32x4*)(out + (size_t)(r + NGW) * DM) + lane;
        f32x4 va[8], vb[8]; float sa = 0.f, sb = 0.f;
#pragma unroll
        for (int j = 0; j < 8; ++j) { va[j] = a4[64 * j]; vb[j] = b4[64 * j]; }
#pragma unroll
        for (int j = 0; j < 8; ++j) { sa += (va[j][0] * va[j][0] + va[j][1] * va[j][1]) + (va[j][2] * va[j][2] + va[j][3] * va[j][3]); sb += (vb[j][0] * vb[j][0] + vb[j][1] * vb[j][1]) + (vb[j][2] * vb[j][2] + vb[j][3] * vb[j][3]); }
#pragma unroll
        for (int o = 1; o < 64; o <<= 1) { sa += __shfl_xor(sa, o); sb += __shfl_xor(sb, o); }
        const float rsa = 1.0f / sqrtf(sa * (1.0f / DM) + 1e-6f), rsb = 1.0f / sqrtf(sb * (1.0f / DM) + 1e-6f);
        const f32x4* g4 = (const f32x4*)final_g + lane;
#pragma unroll
        for (int j = 0; j < 8; ++j) { const f32x4 gg = g4[64 * j]; a4[64 * j] = va[j] * rsa * gg; b4[64 * j] = vb[j] * rsb * gg; }
    }
#ifdef PROBE_A
    PSTAMP2(15, t_probe1);
    GRID_SYNC();
    if (bx == 0) { const unsigned long long dt = __shfl(t_probe1 - t_probe0, 0); const int n = (int)(dt / PDIV); for (int i = tid; i < n && i < 14000; i += 512) out[(size_t)i * 97 + 5] += 0.15f; }
#endif
}

extern "C" void kernel_launch(void* const* d_in, const int* in_sizes, int n_in, void* d_out, int out_size, void* d_ws, size_t ws_size, hipStream_t stream) {
    static int grid = 0;
    if (grid == 0) {
        if (n_in != 21 || out_size != NLAT * DM || ws_size < WS_END) { fprintf(stderr, "kernel_launch: unexpected shapes (n_in %d out %d ws %zu need %zu)\n", n_in, out_size, ws_size, (size_t)WS_END); grid = -1; return; }
        int dev = 0, cus = 0, per_cu = 0;
        (void)hipGetDevice(&dev);
        (void)hipDeviceGetAttribute(&cus, hipDeviceAttributeMultiprocessorCount, dev);
        (void)hipFuncSetAttribute((const void*)fwd_megakernel, hipFuncAttributeMaxDynamicSharedMemorySize, LDS_BYTES);
        (void)hipOccupancyMaxActiveBlocksPerMultiprocessor(&per_cu, (const void*)fwd_megakernel, 512, LDS_BYTES);
        (void)hipGetLastError();
        if (per_cu < 1) fprintf(stderr, "kernel_launch: occupancy query says %d blocks per CU\n", per_cu);
        grid = cus;
    }
    if (grid < 0) return;
    (void)hipMemsetAsync((char*)d_ws, 0, 512 * 1024, stream);
    Args a{};
    for (int i = 0; i < 21; ++i) a.in[i] = (const float*)d_in[i];
    a.out = (float*)d_out; a.ws = (unsigned char*)d_ws;
    void* kargs[] = {&a};
    hipError_t e = hipLaunchCooperativeKernel((const void*)fwd_megakernel, dim3(grid), dim3(512), kargs, LDS_BYTES, stream);
    if (e != hipSuccess) fprintf(stderr, "cooperative launch failed: %s (grid %d)\n", hipGetErrorString(e), grid);
}
```

```cpp
#include <hip/hip_runtime.h>
#include <hip/hip_cooperative_groups.h>
#include <cstdio>
#include <cstdint>
namespace cg = cooperative_groups;

#define LAS __attribute__((address_space(3)))
typedef unsigned short bf16_t;
typedef short bf16x8 __attribute__((ext_vector_type(8)));
typedef short s16x4 __attribute__((ext_vector_type(4)));
typedef float f32x4 __attribute__((ext_vector_type(4)));
typedef unsigned u32x4 __attribute__((ext_vector_type(4)));
typedef unsigned u32x2 __attribute__((ext_vector_type(2)));

constexpr int DM = 2048, SEQ = 4096, NLAT = 8192, NCTX = 512, MT = NLAT + NCTX, CTXL = 256;
constexpr int DFF = 5632, NMOD = 9 * DM;
constexpr int NSLOT = 34;
constexpr float LOG2E = 1.4426950408889634f;

constexpr size_t MiB = 1u << 20;
constexpr size_t WS_MOD = 0;
constexpr size_t WS_BAR = 256 * 1024;
constexpr size_t WS_ROPE = 512 * 1024;
constexpr size_t WS_W13A = 1 * MiB, WS_W2A = 45 * MiB, WS_W13B = 67 * MiB, WS_W2B = 111 * MiB, WS_WIN = 133 * MiB;
constexpr size_t WS_WOA = 177 * MiB, WS_WOB = 185 * MiB, WS_WOUT = 189 * MiB, WS_POOLW = 197 * MiB;
constexpr size_t WS_AN = 198 * MiB;
constexpr size_t WS_H = 232 * MiB;
constexpr size_t WS_HC1 = 326 * MiB;
constexpr size_t WS_K = 330 * MiB, WS_Q = 347 * MiB, WS_V = 363 * MiB, WS_G = 397 * MiB, WS_PIN = 429 * MiB, WS_GA = 445 * MiB, WS_GB = 477 * MiB;
constexpr size_t WS_POOLED = 509 * MiB, WS_PM = 525 * MiB, WS_END = 541 * MiB;
constexpr int LDS_BYTES = 147456;

__device__ __forceinline__ unsigned f2bf(float f) { unsigned u = __builtin_bit_cast(unsigned, f); return (u + 0x7fffu + ((u >> 16) & 1u)) >> 16; }
typedef float f32x2_t __attribute__((ext_vector_type(2))); typedef __bf16 bf16x2_t __attribute__((ext_vector_type(2)));
__device__ __forceinline__ unsigned pk2(float lo, float hi) { f32x2_t v = {lo, hi}; bf16x2_t b = __builtin_convertvector(v, bf16x2_t); return __builtin_bit_cast(unsigned, b); }
__device__ __forceinline__ float bflo(unsigned w) { return __builtin_bit_cast(float, w << 16); }
__device__ __forceinline__ float bfhi(unsigned w) { return __builtin_bit_cast(float, w & 0xffff0000u); }
__device__ __forceinline__ float bf1(short s) { return __builtin_bit_cast(float, ((unsigned)(unsigned short)s) << 16); }
__device__ __forceinline__ float fsilu(float a) { return a * __builtin_amdgcn_rcpf(1.0f + __builtin_amdgcn_exp2f(-a * LOG2E)); }
__device__ __forceinline__ float fsigm(float a) { return __builtin_amdgcn_rcpf(1.0f + __builtin_amdgcn_exp2f(-a * LOG2E)); }
__device__ __forceinline__ float wave_sum(float v) {
#pragma unroll
    for (int o = 1; o < 64; o <<= 1) v += __shfl_xor(v, o);
    return v;
}

namespace pg8 {
constexpr int BM = 256, BK = 64, HALF = 128, HTB = HALF * BK * 2, STAGE_BYTES = 8 * HTB, NXCD = 8, WGM = 8;
__device__ __forceinline__ int lds_byte(int r, int c) { const int st = (r >> 4) * 2 + (c >> 5), rr = r & 15, cc = c & 31, ob = rr * 64 + cc * 2; return st * 1024 + (ob ^ (((ob >> 9) & 1) << 5)); }
__device__ __forceinline__ void stage_rc(int b, int& R, int& C) { const int st = b / 1024, sb = b % 1024, swz = sb ^ (((sb >> 9) & 1) << 5); R = (st >> 1) * 16 + swz / 64; C = (st & 1) * 32 + (swz % 64) / 2; }
__device__ __forceinline__ int perm32(int rho) { const int n = rho >> 4, i = rho & 15; return 8 * (i >> 2) + 4 * n + (i & 3); }
struct Unit { int pm, pn, k0, nt; };
struct Gemm { const bf16_t* A; const bf16_t* Bt; int lda, ldb; };

struct MixOrder {
    int nMl, nN, nLat, nNc, nCtx, G, c, ntf, nsp, ntp;
    __device__ void init(int nMl_, int nN_, int nMc_, int nNc_, int G_, int c_, int ntf_, int nsp_ = 1) { nMl = nMl_; nN = nN_; nLat = nMl_ * nN_; nNc = nNc_; nsp = nsp_; nCtx = nMc_ * nNc_ * nsp_; G = G_; c = c_; ntf = ntf_; ntp = ntf_ / nsp_; }
    __device__ bool next(int i, Unit& u) const {
        long L = (long)i * G + c;
        if (L < nLat) {
            const int nwg = nLat, nM = nMl;
            int wgid = (int)L; { const int q = nwg / NXCD, r = nwg % NXCD, xcd = wgid % NXCD, off = wgid / NXCD; wgid = (xcd < r ? xcd * (q + 1) : r * (q + 1) + (xcd - r) * q) + off; }
            const int nig = WGM * nN, gid = wgid / nig, fm = gid * WGM, gsz = (nM - fm) < WGM ? (nM - fm) : WGM;
            u.pm = fm + ((wgid % nig) % gsz); u.pn = (wgid % nig) / gsz; u.k0 = 0; u.nt = ntf; return true;
        }
        L -= nLat;
        if (L < nCtx) { const int t = (int)(L / nsp), p = (int)(L % nsp); u.pm = nMl + t / nNc; u.pn = t % nNc; u.k0 = p * ntp; u.nt = ntp; return true; }
        return false;
    }
};

__device__ __forceinline__ unsigned cvt_pk_bf16(float lo, float hi) { return pk2(lo, hi); }
__device__ __forceinline__ u32x4 pack8(const f32x4 a, const f32x4 b) { u32x4 w; w.x = cvt_pk_bf16(a[0], a[1]); w.y = cvt_pk_bf16(a[2], a[3]); w.z = cvt_pk_bf16(b[0], b[1]); w.w = cvt_pk_bf16(b[2], b[3]); return w; }

struct EpiSwiglu {
    static constexpr bool PERM = true, HOOK = false;
    bf16_t* O; int ldc;
    __device__ __forceinline__ void operator()(const f32x4 (&acc)[2][2][4][2], const Unit& u, int wr, int wc, int fr, int fq) const {
        const int row0 = u.pm * BM + wr * 64 + fr, col0 = u.pn * HALF + wc * 32 + 8 * fq;
#pragma unroll
        for (int ai = 0; ai < 2; ++ai)
#pragma unroll
            for (int m = 0; m < 4; ++m) {
                f32x4 h0, h1;
#pragma unroll
                for (int e = 0; e < 4; ++e) { h0[e] = fsilu(acc[ai][0][m][0][e]) * acc[ai][1][m][0][e]; h1[e] = fsilu(acc[ai][0][m][1][e]) * acc[ai][1][m][1][e]; }
                *(u32x4*)(O + (size_t)(row0 + ai * HALF + m * 16) * ldc + col0) = pack8(h0, h1);
            }
    }
};
struct EpiResid {
    static constexpr bool PERM = false, HOOK = false;
    const float* res_lat; float* out_lat; float* out_ctx; const float* mod; int gidx; float scale;
    __device__ __forceinline__ void operator()(const f32x4 (&acc)[2][2][4][2], const Unit& u, int wr, int wc, int fr, int fq) const {
        const bool ctx = u.pm >= 32; const int bsel = ctx ? 2 : (u.pm >= 16 ? 1 : 0);
        const int row0 = (ctx ? (u.pm - 32) : u.pm) * BM + wr * 64 + fr, col0 = u.pn * BM + wc * 32 + 4 * fq;
        const float* gate = mod + bsel * NMOD + gidx * DM;
        f32x4 gv[2][2];
#pragma unroll
        for (int bj = 0; bj < 2; ++bj)
#pragma unroll
            for (int n = 0; n < 2; ++n) gv[bj][n] = *(const f32x4*)(gate + col0 + bj * HALF + n * 16) * scale;
        if (!ctx) {
#pragma unroll
            for (int ai = 0; ai < 2; ++ai)
#pragma unroll
                for (int m = 0; m < 4; ++m) { const size_t off = (size_t)(row0 + ai * HALF + m * 16) * DM + col0;
#pragma unroll
                    for (int bj = 0; bj < 2; ++bj)
#pragma unroll
                        for (int n = 0; n < 2; ++n) { const size_t o = off + bj * HALF + n * 16; const f32x4 r = *(const f32x4*)(res_lat + o); *(f32x4*)(out_lat + o) = r + gv[bj][n] * acc[ai][bj][m][n]; } }
        } else {
#pragma unroll
            for (int ai = 0; ai < 2; ++ai)
#pragma unroll
                for (int m = 0; m < 4; ++m) { const size_t off = (size_t)(row0 + ai * HALF + m * 16) * DM + col0;
#pragma unroll
                    for (int bj = 0; bj < 2; ++bj)
#pragma unroll
                        for (int n = 0; n < 2; ++n) *(f32x4*)(out_ctx + (size_t)(u.k0 / u.nt) * (NCTX * DM) + off + bj * HALF + n * 16) = gv[bj][n] * acc[ai][bj][m][n]; }
        }
    }
};
struct EpiIn {
    static constexpr bool PERM = true, HOOK = false;
    bf16_t *K, *Q, *V, *G, *PIN, *GA, *GB; const float* bgate; const float* rope;
    __device__ __forceinline__ void operator()(const f32x4 (&acc)[2][2][4][2], const Unit& u, int wr, int wc, int fr, int fq) const {
        const int row0 = u.pm * BM + wr * 64 + fr, cb = wc * 32 + 8 * fq, pn = u.pn;
        if (pn < 4 || (pn >= 12 && pn < 16)) {
            const bool isk = pn < 4; bf16_t* dst = isk ? K : Q; const int hcol = (isk ? pn : pn - 12) * BM; const float sc = isk ? 0.08838834764831845f : 1.0f;
            const bool lat = u.pm < 32; const int i0 = (16 * wc + 4 * fq) & 31;
#pragma unroll
            for (int ai = 0; ai < 2; ++ai)
#pragma unroll
                for (int m = 0; m < 4; ++m) {
                    const int row = row0 + ai * HALF + m * 16;
                    f32x4 cs0 = {1.f, 0.f, 1.f, 0.f}, cs1 = {1.f, 0.f, 1.f, 0.f};
                    if (lat) { const int t = row & 4095; const int pos = (wc < 2) ? (t >> 6) : (t & 63); const float* rp = rope + (pos * 32 + i0) * 2; cs0 = *(const f32x4*)rp; cs1 = *(const f32x4*)(rp + 4); }
                    const float c_[4] = {cs0[0], cs0[2], cs1[0], cs1[2]}, s_[4] = {cs0[1], cs0[3], cs1[1], cs1[3]};
#pragma unroll
                    for (int bj = 0; bj < 2; ++bj) { const f32x4 x1 = acc[ai][bj][m][0], x2 = acc[ai][bj][m][1]; f32x4 o1, o2;
#pragma unroll
                        for (int e = 0; e < 4; ++e) { o1[e] = (x1[e] * c_[e] - x2[e] * s_[e]) * sc; o2[e] = (x1[e] * s_[e] + x2[e] * c_[e]) * sc; }
                        *(u32x4*)(dst + (size_t)row * 1024 + hcol + bj * HALF + cb) = pack8(o1, o2); }
                }
        } else if (pn < 12) {
#pragma unroll
            for (int ai = 0; ai < 2; ++ai)
#pragma unroll
                for (int m = 0; m < 4; ++m)
#pragma unroll
                    for (int bj = 0; bj < 2; ++bj) *(u32x4*)(V + (size_t)(row0 + ai * HALF + m * 16) * DM + (pn - 4) * BM + bj * HALF + cb) = pack8(acc[ai][bj][m][0], acc[ai][bj][m][1]);
        } else if (pn < 24) {
#pragma unroll
            for (int ai = 0; ai < 2; ++ai)
#pragma unroll
                for (int m = 0; m < 4; ++m)
#pragma unroll
                    for (int bj = 0; bj < 2; ++bj) { f32x4 a = acc[ai][bj][m][0], b = acc[ai][bj][m][1];
#pragma unroll
                        for (int e = 0; e < 4; ++e) { a[e] = fsilu(a[e]); b[e] = fsilu(b[e]); }
                        *(u32x4*)(G + (size_t)(row0 + ai * HALF + m * 16) * DM + (pn - 16) * BM + bj * HALF + cb) = pack8(a, b); }
        } else if (pn < 28) {
#pragma unroll
            for (int ai = 0; ai < 2; ++ai)
#pragma unroll
                for (int m = 0; m < 4; ++m)
#pragma unroll
                    for (int bj = 0; bj < 2; ++bj) *(u32x4*)(PIN + (size_t)(row0 + ai * HALF + m * 16) * 1024 + (pn - 24) * BM + bj * HALF + cb) = pack8(acc[ai][bj][m][0], acc[ai][bj][m][1]);
        } else {
            const int gc = (pn - 28) * HALF + cb;
            const f32x4 a0 = *(const f32x4*)(bgate + gc), a1 = *(const f32x4*)(bgate + gc + 4), b0 = *(const f32x4*)(bgate + DM + gc), b1 = *(const f32x4*)(bgate + DM + gc + 4);
#pragma unroll
            for (int ai = 0; ai < 2; ++ai)
#pragma unroll
                for (int m = 0; m < 4; ++m) { const f32x4 xa0 = acc[ai][0][m][0] + a0, xa1 = acc[ai][0][m][1] + a1, xb0 = acc[ai][1][m][0] + b0, xb1 = acc[ai][1][m][1] + b1;
                    f32x4 r0, r1, g0, g1;
#pragma unroll
                    for (int e = 0; e < 4; ++e) { const float ea0 = 1.0f + __builtin_amdgcn_exp2f(-xa0[e] * LOG2E), ea1 = 1.0f + __builtin_amdgcn_exp2f(-xa1[e] * LOG2E), eb0 = 1.0f + __builtin_amdgcn_exp2f(-xb0[e] * LOG2E), eb1 = 1.0f + __builtin_amdgcn_exp2f(-xb1[e] * LOG2E);
                        r0[e] = eb0 * __builtin_amdgcn_rcpf(ea0); r1[e] = eb1 * __builtin_amdgcn_rcpf(ea1); g0[e] = __builtin_amdgcn_rcpf(eb0); g1[e] = __builtin_amdgcn_rcpf(eb1); }
                    const size_t o = (size_t)(row0 + ai * HALF + m * 16) * DM + gc;
                    *(u32x4*)(GA + o) = pack8(r0, r1); *(u32x4*)(GB + o) = pack8(g0, g1); }
        }
    }
};
struct EpiMerge {
    static constexpr bool PERM = true, HOOK = true;
    const bf16_t* RA; const bf16_t* GB; bf16_t* MM; int hook_t;
    __device__ __forceinline__ void hook(f32x4 (&acc)[2][2][4][2], const Unit& u, int wr, int wc, int fr, int fq) const {
        int row0 = u.pm * BM + wr * 64 + fr; const int col0 = u.pn * BM + wc * 32 + 8 * fq;
        asm volatile("" : "+v"(row0));
#pragma unroll
        for (int ai = 0; ai < 2; ++ai)
#pragma unroll
            for (int m = 0; m < 4; ++m)
#pragma unroll
                for (int bj = 0; bj < 2; ++bj) { const u32x4 g = *(const u32x4*)(RA + (size_t)(row0 + ai * HALF + m * 16) * DM + col0 + bj * HALF);
                    acc[ai][bj][m][0] *= (f32x4){bflo(g.x), bfhi(g.x), bflo(g.y), bfhi(g.y)}; acc[ai][bj][m][1] *= (f32x4){bflo(g.z), bfhi(g.z), bflo(g.w), bfhi(g.w)};
                    if (bj == 1 && (m & 1)) { asm volatile("" ::: "memory"); __builtin_amdgcn_sched_barrier(0); } }
    }
    __device__ __forceinline__ void operator()(const f32x4 (&acc)[2][2][4][2], const Unit& u, int wr, int wc, int fr, int fq) const {
        const int row0 = u.pm * BM + wr * 64 + fr, col0 = u.pn * BM + wc * 32 + 8 * fq;
#pragma unroll
        for (int ai = 0; ai < 2; ++ai)
#pragma unroll
            for (int m = 0; m < 4; ++m)
#pragma unroll
                for (int bj = 0; bj < 2; ++bj) { const size_t o = (size_t)(row0 + ai * HALF + m * 16) * DM + col0 + bj * HALF; const u32x4 g = *(const u32x4*)(GB + o);
                    const f32x4 g0 = {bflo(g.x), bfhi(g.x), bflo(g.y), bfhi(g.y)}, g1 = {bflo(g.z), bfhi(g.z), bflo(g.w), bfhi(g.w)};
                    *(u32x4*)(MM + o) = pack8(g0 * acc[ai][bj][m][0], g1 * acc[ai][bj][m][1]); }
    }
};
struct EpiPool {
    static constexpr bool PERM = true, HOOK = false;
    bf16_t* PM; const float* pscale; int g;
    __device__ __forceinline__ void operator()(const f32x4 (&acc)[2][2][4][2], const Unit& u, int wr, int wc, int fr, int fq) const {
        const int row0 = u.pm * BM + wr * 64 + fr, col0 = g * BM + wc * 32 + 8 * fq;
#pragma unroll
        for (int bj = 0; bj < 2; ++bj) { const f32x4 s0 = *(const f32x4*)(pscale + col0 + bj * HALF), s1 = *(const f32x4*)(pscale + col0 + bj * HALF + 4);
#pragma unroll
            for (int ai = 0; ai < 2; ++ai)
#pragma unroll
                for (int m = 0; m < 4; ++m) *(u32x4*)(PM + (size_t)(row0 + ai * HALF + m * 16) * 3072 + 2048 + col0 + bj * HALF) = pack8(acc[ai][bj][m][0] * s0, acc[ai][bj][m][1] * s1); }
    }
};

template <class Epi, class Sched, bool ALIGN_EPI>
__device__ __forceinline__ void gemm_phase(LAS unsigned char* lds, const Gemm g, const Sched& S, const Epi& E) {
    int tid = threadIdx.x; asm volatile("" : "+v"(tid));
    const int wid = __builtin_amdgcn_readfirstlane(tid >> 6), lane = tid & 63, wr = wid >> 2, wc = wid & 3, fr = lane & 15, fq = lane >> 4;
    unsigned voffA[2], voffB[2];
#pragma unroll
    for (int i = 0; i < 2; ++i) { int R, C; stage_rc(tid * 16 + i * 8192, R, C); const int Rb = Epi::PERM ? ((R & ~31) + perm32(R & 31)) : R;
        voffA[i] = (unsigned)(R * g.lda + C) * 2u; voffB[i] = (unsigned)(Rb * g.ldb + C) * 2u; }
    const size_t kstep = (size_t)(BK * 2);
    const size_t hstepA = (size_t)HALF * g.lda * 2, hstepB = (size_t)HALF * g.ldb * 2;
    const size_t tstepA = 2 * hstepA, tstepB = 2 * hstepB;
    const unsigned ldsw = (unsigned)wid * 1024u;
    const int aoff = lds_byte(wr * 64 + fr, fq * 8), boff = lds_byte(wc * 32 + fr, fq * 8);
#define PG8_SA(b, h) (((b) * 2 + (h)) * HTB)
#define PG8_SB(b, h) ((4 + (b) * 2 + (h)) * HTB)
#define PG8_STAGE(bufoff, gbase, voff) do { _Pragma("unroll") for (int _i = 0; _i < 2; ++_i) \
        __builtin_amdgcn_global_load_lds((const unsigned*)((const char*)(gbase) + (voff)[_i]), (LAS unsigned*)(lds + (bufoff) + ldsw + _i * 8192), 16, 0, 0); } while (0)
#define PG8_LDA(dst, b, h) do { _Pragma("unroll") for (int m = 0; m < 4; ++m) _Pragma("unroll") for (int k = 0; k < 2; ++k) dst[m][k] = *(const LAS bf16x8*)(lds + PG8_SA(b, h) + aoff + m * 2048 + k * 1024); } while (0)
#define PG8_LDB(dst, b, h) do { _Pragma("unroll") for (int n = 0; n < 2; ++n) _Pragma("unroll") for (int k = 0; k < 2; ++k) dst[n][k] = *(const LAS bf16x8*)(lds + PG8_SB(b, h) + boff + n * 2048 + k * 1024); } while (0)
#define PG8_MMA(ai, bj, At, Bt) do { __builtin_amdgcn_s_setprio(1); _Pragma("unroll") for (int m = 0; m < 4; ++m) _Pragma("unroll") for (int n = 0; n < 2; ++n) _Pragma("unroll") for (int k = 0; k < 2; ++k) \
        acc[ai][bj][m][n] = __builtin_amdgcn_mfma_f32_16x16x32_bf16(Bt[n][k], At[m][k], acc[ai][bj][m][n], 0, 0, 0); __builtin_amdgcn_s_setprio(0); } while (0)
#define PG8_WAIT_V(n) asm volatile("s_waitcnt vmcnt(" #n ")" ::: "memory")
#define PG8_WAIT_L(n) asm volatile("s_waitcnt lgkmcnt(" #n ")" ::: "memory")
#define PG8_BAR __builtin_amdgcn_s_barrier()
#define PG8_SCHED __builtin_amdgcn_sched_barrier(0)
    Unit cur, nxt; int ui = 0;
    if (!S.next(0, cur)) return;
    f32x4 acc[2][2][4][2];
#pragma unroll
    for (int a = 0; a < 2; ++a)
#pragma unroll
        for (int b = 0; b < 2; ++b)
#pragma unroll
            for (int m = 0; m < 4; ++m)
#pragma unroll
                for (int n = 0; n < 2; ++n) acc[a][b][m][n] = (f32x4){0.f, 0.f, 0.f, 0.f};
    bf16x8 At[4][2], B0[2][2], B1[2][2];
    const char* cA = (const char*)g.A + (size_t)cur.pm * tstepA + (size_t)cur.k0 * kstep; const char* cB = (const char*)g.Bt + (size_t)cur.pn * tstepB + (size_t)cur.k0 * kstep;
    PG8_STAGE(PG8_SB(0, 0), cB, voffB); PG8_STAGE(PG8_SB(0, 1), cB + hstepB, voffB); PG8_STAGE(PG8_SA(0, 0), cA, voffA); PG8_STAGE(PG8_SA(0, 1), cA + hstepA, voffA);
    if (wr == 1) PG8_BAR;
    PG8_WAIT_V(2); PG8_BAR;
    PG8_STAGE(PG8_SB(1, 0), cB + kstep, voffB); PG8_STAGE(PG8_SA(1, 0), cA + kstep, voffA); PG8_STAGE(PG8_SB(1, 1), cB + hstepB + kstep, voffB);
    PG8_WAIT_V(6); PG8_BAR;
    for (;;) {
        const bool has_next = S.next(ui + 1, nxt);
        const char* nA = has_next ? (const char*)g.A + (size_t)nxt.pm * tstepA + (size_t)nxt.k0 * kstep : cA; const char* nB = has_next ? (const char*)g.Bt + (size_t)nxt.pn * tstepB + (size_t)nxt.k0 * kstep : cB;
        const int nt = cur.nt;
#pragma unroll 1
        for (int t = 0; t < nt; t += 2) {
            const bool last = (t == nt - 2);
            if constexpr (Epi::HOOK) { if (t == E.hook_t) { __builtin_amdgcn_sched_barrier(0); E.hook(acc, cur, wr, wc, fr, fq); __builtin_amdgcn_sched_barrier(0); } }
            const char* a1 = cA + (size_t)(t + 1) * kstep;
            const char* a2 = last ? nA : cA + (size_t)(t + 2) * kstep; const char* b2 = last ? nB : cB + (size_t)(t + 2) * kstep;
            const char* a3 = a2 + kstep; const char* b3 = b2 + kstep;
            PG8_LDB(B0, 0, 0); PG8_LDB(B1, 0, 1); PG8_SCHED; PG8_LDA(At, 0, 0); PG8_STAGE(PG8_SA(1, 1), a1 + hstepA, voffA);
            PG8_WAIT_V(8); PG8_WAIT_L(0); PG8_BAR; PG8_MMA(0, 0, At, B0); PG8_MMA(0, 1, At, B1); PG8_BAR; PG8_SCHED;
            PG8_LDA(At, 0, 1); PG8_STAGE(PG8_SB(0, 0), b2, voffB); PG8_STAGE(PG8_SB(0, 1), b2 + hstepB, voffB); PG8_STAGE(PG8_SA(0, 0), a2, voffA);
            PG8_WAIT_V(8); PG8_WAIT_L(0); PG8_BAR; PG8_MMA(1, 0, At, B0); PG8_MMA(1, 1, At, B1); PG8_BAR; PG8_SCHED;
            PG8_LDB(B0, 1, 0); PG8_LDB(B1, 1, 1); PG8_SCHED; PG8_LDA(At, 1, 0); PG8_STAGE(PG8_SA(0, 1), a2 + hstepA, voffA);
            PG8_WAIT_V(8); PG8_WAIT_L(0); PG8_BAR; PG8_MMA(0, 0, At, B0); PG8_MMA(0, 1, At, B1); PG8_BAR; PG8_SCHED;
            PG8_LDA(At, 1, 1); PG8_STAGE(PG8_SB(1, 0), b3, voffB); PG8_STAGE(PG8_SB(1, 1), b3 + hstepB, voffB); PG8_STAGE(PG8_SA(1, 0), a3, voffA);
            PG8_WAIT_V(8); PG8_WAIT_L(0); PG8_BAR; PG8_MMA(1, 0, At, B0); PG8_MMA(1, 1, At, B1); PG8_BAR; PG8_SCHED;
        }
        if constexpr (ALIGN_EPI) { if (wr == 0) PG8_BAR; }
        E(acc, cur, wr, wc, fr, fq);
        if (!has_next) break;
#pragma unroll
        for (int a = 0; a < 2; ++a)
#pragma unroll
            for (int b = 0; b < 2; ++b)
#pragma unroll
                for (int m = 0; m < 4; ++m)
#pragma unroll
                    for (int n = 0; n < 2; ++n) acc[a][b][m][n] = (f32x4){0.f, 0.f, 0.f, 0.f};
        cur = nxt; cA = nA; cB = nB; ++ui;
        if constexpr (ALIGN_EPI) { if (wr == 1) PG8_BAR; }
    }
    PG8_WAIT_V(0);
    if constexpr (!ALIGN_EPI) { if (wr == 0) PG8_BAR; }
    PG8_BAR;
#undef PG8_SA
#undef PG8_SB
#undef PG8_STAGE
#undef PG8_LDA
#undef PG8_LDB
#undef PG8_MMA
#undef PG8_WAIT_V
#undef PG8_WAIT_L
#undef PG8_BAR
#undef PG8_SCHED
}
}


#define XB_TMO      128
#define XB_XCNT(j)  (256  + 64 * (j))
#define XB_XSUB(j)  (1280 + 64 * (j))
#define XB_XGEN(j)  (2304 + 64 * (j))
#define XB_TOP      3328
#define XB_TOPGEN   3392
#define XCD_BAR_WORDS 3456
#define XB_SPIN_CAP (1u << 18)
__device__ __forceinline__ unsigned xb_ld(unsigned* p)              { return __hip_atomic_load(p, __ATOMIC_RELAXED, __HIP_MEMORY_SCOPE_AGENT); }
__device__ __forceinline__ unsigned xb_add(unsigned* p, unsigned v) { return __hip_atomic_fetch_add(p, v, __ATOMIC_RELAXED, __HIP_MEMORY_SCOPE_AGENT); }
__device__ __forceinline__ unsigned xb_xcc_id() { return (unsigned)__builtin_amdgcn_s_getreg((3 << 11) | 20) & 0xFu; }
#define XB_SPIN(cond, bar) do { unsigned _sp = 0; while (cond) { __builtin_amdgcn_s_sleep(1); \
    if ((++_sp & 255u) == 0u) { if (xb_ld(&(bar)[XB_TMO])) break; if (_sp > XB_SPIN_CAP) { atomicAdd(&(bar)[XB_TMO], 1u); break; } } } } while (0)
struct XcdBarrier { unsigned* bar; unsigned x; volatile LAS unsigned* st; };
__device__ __forceinline__ XcdBarrier xcd_barrier_post(unsigned* bar, volatile LAS unsigned* st) {
    XcdBarrier b; b.bar = bar; b.x = xb_xcc_id(); b.st = st;
    if (threadIdx.x == 0) (void)xb_add(&bar[XB_XCNT(b.x)], 1u);
    return b;
}
__device__ __forceinline__ void xcd_barrier_complete(unsigned* bar, unsigned x, unsigned& nloc, unsigned& nx) {
    const unsigned G = gridDim.x * gridDim.y * gridDim.z;
    unsigned sum, cnt, mine, sp = 0u;
    for (;;) {
        sum = 0u; cnt = 0u; mine = 0u;
#pragma unroll
        for (unsigned j = 0; j < 16; ++j) { const unsigned c = xb_ld(&bar[XB_XCNT(j)]); sum += c; cnt += (c > 0u) ? 1u : 0u; mine = (j == x) ? c : mine; }
        if (sum == G) break;
        __builtin_amdgcn_s_sleep(1);
        if ((++sp & 255u) == 0u) { if (xb_ld(&bar[XB_TMO])) break; if (sp > XB_SPIN_CAP) { atomicAdd(&bar[XB_TMO], 1u); break; } }
    }
    nloc = mine > 0u ? mine : 1u; nx = cnt > 0u ? cnt : 1u;
}
__device__ __forceinline__ void xcd_barrier(const XcdBarrier& b) {
    asm volatile("s_waitcnt vmcnt(0)" ::: "memory");
    __syncthreads();
    if (threadIdx.x == 0) {
        unsigned* bar = b.bar;
        __builtin_amdgcn_s_waitcnt(0);
        unsigned nloc = b.st[0], nx = b.st[1];
        if (nloc == 0u) { xcd_barrier_complete(bar, b.x, nloc, nx); b.st[0] = nloc; b.st[1] = nx; }
        const unsigned old = xb_add(&bar[XB_XSUB(b.x)], 1u);
        const unsigned gen = old / nloc;
        if (old + 1u == (gen + 1u) * nloc) {
            __builtin_amdgcn_fence(__ATOMIC_RELEASE, "agent");
            asm volatile("s_waitcnt vmcnt(0)" ::: "memory");
            const unsigned og = xb_add(&bar[XB_TOP], 1u);
            const unsigned tg = og / nx;
            if (og + 1u == (tg + 1u) * nx) xb_add(&bar[XB_TOPGEN], 1u);
            else XB_SPIN(xb_ld(&bar[XB_TOPGEN]) == tg, bar);
            __builtin_amdgcn_fence(__ATOMIC_ACQUIRE, "agent");
            xb_add(&bar[XB_XGEN(b.x)], 1u);
            asm volatile("s_waitcnt vmcnt(0)" ::: "memory");
        } else {
            XB_SPIN(xb_ld(&bar[XB_XGEN(b.x)]) == gen, bar);
            __builtin_amdgcn_fence(__ATOMIC_ACQUIRE, "agent");
            asm volatile("s_waitcnt vmcnt(0)" ::: "memory");
        }
    }
    __syncthreads();
}
struct Args { const float* in[21]; float* out; unsigned char* ws; int pad0, pad1; };
#define LDS_WAIT() asm volatile("s_waitcnt lgkmcnt(0)" ::: "memory")
#define GRID_SYNC() xcd_barrier(xbar)

__device__ __forceinline__ int dest_row(int mode, int n) {
    if (mode == 1) { const int half = n >= DFF ? 1 : 0; const int j = n - half * DFF; return ((j >> 7) << 8) + (half << 7) + (j & 127); }
    if (mode == 2) { if (n < 1024 || (n >= 3072 && n < 4096)) { const int d = n & 127, half = d >> 6, dd = d & 63, i = dd & 31, nb = dd >> 5, rho = 32 * half + i;
            return (n & ~127) + 32 * (rho >> 4) + 8 * ((rho >> 2) & 3) + 4 * nb + (rho & 3); } return n; }
    if (mode == 3) { const int half = n >= DM ? 1 : 0; const int j = n - half * DM; return ((j >> 7) << 8) + (half << 7) + (j & 127); }
    return n;
}
__device__ __forceinline__ void tr_item(const float* W, int K, int N, bf16_t* WT, int row_off, int mode, LAS float* scr, int item, int lane, int ldk = 0, int koff = 0) {
    if (ldk == 0) ldk = K;
    const int nblk = N >> 6, kb = item / nblk, nb = item - kb * nblk, k0 = kb << 6, n0 = nb << 6;
    f32x4 v[16];
#pragma unroll
    for (int i = 0; i < 16; ++i) { const int idx = i * 64 + lane, kk = idx >> 4, c4 = idx & 15; v[i] = *(const f32x4*)(W + (size_t)(k0 + kk) * N + n0 + 4 * c4); }
#pragma unroll
    for (int i = 0; i < 16; ++i) { const int idx = i * 64 + lane, kk = idx >> 4, c4 = idx & 15; LAS float* s = scr + kk * 65 + 4 * c4; s[0] = v[i][0]; s[1] = v[i][1]; s[2] = v[i][2]; s[3] = v[i][3]; }
    LDS_WAIT(); asm volatile("" ::: "memory");
    const int c = lane & 7;
#pragma unroll
    for (int j = 0; j < 8; ++j) { const int n = (lane >> 3) + 8 * j; const LAS float* s = scr + (8 * c) * 65 + n;
        u32x4 o; o.x = pk2(s[0], s[65]); o.y = pk2(s[2 * 65], s[3 * 65]); o.z = pk2(s[4 * 65], s[5 * 65]); o.w = pk2(s[6 * 65], s[7 * 65]);
        *(u32x4*)(WT + (size_t)(row_off + dest_row(mode, n0 + n)) * ldk + koff + k0 + 8 * c) = o; }
    LDS_WAIT(); asm volatile("" ::: "memory");
}

__device__ __forceinline__ void norm_rows(const float* src_lat, const float* gvec, const float* mod, int shidx, int scidx, bf16_t* dst, int gw, int NGW, int lane) {
    for (int r0 = gw; r0 < NLAT; r0 += 2 * NGW) {
        const int r1 = r0 + NGW;
        const f32x4* a4 = (const f32x4*)(src_lat + (size_t)r0 * DM) + lane; const f32x4* b4 = (const f32x4*)(src_lat + (size_t)r1 * DM) + lane;
        f32x4 va[8], vb[8];
#pragma unroll
        for (int j = 0; j < 8; ++j) { va[j] = a4[64 * j]; vb[j] = b4[64 * j]; }
        float sa = 0.f, sb = 0.f;
#pragma unroll
        for (int j = 0; j < 8; ++j) { sa += (va[j][0] * va[j][0] + va[j][1] * va[j][1]) + (va[j][2] * va[j][2] + va[j][3] * va[j][3]); sb += (vb[j][0] * vb[j][0] + vb[j][1] * vb[j][1]) + (vb[j][2] * vb[j][2] + vb[j][3] * vb[j][3]); }
#pragma unroll
        for (int o = 1; o < 64; o <<= 1) { sa += __shfl_xor(sa, o); sb += __shfl_xor(sb, o); }
        const float rsa = 1.0f / sqrtf(sa * (1.0f / DM) + 1e-6f), rsb = 1.0f / sqrtf(sb * (1.0f / DM) + 1e-6f);
        const int bsA = r0 < SEQ ? 0 : 1, bsB = r1 < SEQ ? 0 : 1;
        const f32x4* g4 = (const f32x4*)gvec + lane;
        const f32x4* scA = (const f32x4*)(mod + bsA * NMOD + scidx * DM) + lane; const f32x4* shA = (const f32x4*)(mod + bsA * NMOD + shidx * DM) + lane;
        const f32x4* scB = (const f32x4*)(mod + bsB * NMOD + scidx * DM) + lane; const f32x4* shB = (const f32x4*)(mod + bsB * NMOD + shidx * DM) + lane;
        u32x2* oA = (u32x2*)(dst + (size_t)r0 * DM) + lane; u32x2* oB = (u32x2*)(dst + (size_t)r1 * DM) + lane;
#pragma unroll
        for (int j = 0; j < 8; ++j) { const f32x4 gg = g4[64 * j];
            const f32x4 ya = va[j] * rsa * gg, oa = ya * (scA[64 * j] + 1.0f) + shA[64 * j]; u32x2 w; w.x = pk2(oa[0], oa[1]); w.y = pk2(oa[2], oa[3]); oA[64 * j] = w;
            const f32x4 yb = vb[j] * rsb * gg, ob = yb * (scB[64 * j] + 1.0f) + shB[64 * j]; u32x2 w2; w2.x = pk2(ob[0], ob[1]); w2.y = pk2(ob[2], ob[3]); oB[64 * j] = w2; }
    }
}
__device__ __forceinline__ void norm_ctx_rows(const float* src_ctx, const float* gvec, const float* mod, int shidx, int scidx, bf16_t* dst, int gw, int NGW, int lane, const float* part, int npart) {
    for (int c = gw; c < 4 * NCTX; c += NGW) {
        if (c & 3) continue;
        const int rc = c >> 2;
        const f32x4* a4 = (const f32x4*)(src_ctx + (size_t)rc * DM) + lane;
        f32x4 v[8];
#pragma unroll
        for (int j = 0; j < 8; ++j) v[j] = a4[64 * j];
        const f32x4* p4 = (const f32x4*)(part + (size_t)rc * DM) + lane;
        for (int p = 0; p < npart; ++p) {
#pragma unroll
            for (int j = 0; j < 8; ++j) v[j] += p4[(size_t)p * (NCTX * DM / 4) + 64 * j]; }
        float ss = 0.f;
#pragma unroll
        for (int j = 0; j < 8; ++j) ss += (v[j][0] * v[j][0] + v[j][1] * v[j][1]) + (v[j][2] * v[j][2] + v[j][3] * v[j][3]);
        const float rstd = 1.0f / sqrtf(wave_sum(ss) * (1.0f / DM) + 1e-6f);
        const f32x4* g4 = (const f32x4*)gvec + lane; const f32x4* sc4 = (const f32x4*)(mod + 2 * NMOD + scidx * DM) + lane; const f32x4* sh4 = (const f32x4*)(mod + 2 * NMOD + shidx * DM) + lane;
        u32x2* o8 = (u32x2*)(dst + (size_t)(NLAT + rc) * DM) + lane;
#pragma unroll
        for (int j = 0; j < 8; ++j) { const f32x4 y = v[j] * rstd * g4[64 * j]; const f32x4 o = y * (sc4[64 * j] + 1.0f) + sh4[64 * j]; u32x2 w; w.x = pk2(o[0], o[1]); w.y = pk2(o[2], o[3]); o8[64 * j] = w; }
    }
}

__device__ __forceinline__ s16x4 lds_tr(const LAS unsigned char* p) { return __builtin_amdgcn_ds_read_tr16_b64_v4i16((LAS s16x4*)p); }
__device__ __forceinline__ bf16x8 lds_tr8(const LAS unsigned char* base, int pitch, int k0, int n0, int lane) {
    const int g = lane >> 4, q = (lane & 15) >> 2, p = lane & 3;
    const LAS unsigned char* a = base + (k0 + 8 * g + q) * pitch + (n0 + 4 * p) * 2;
    const s16x4 lo = lds_tr(a), hi = lds_tr(a + 4 * pitch);
    return (bf16x8){lo[0], lo[1], lo[2], lo[3], hi[0], hi[1], hi[2], hi[3]};
}
__device__ __forceinline__ float log2_gamma(const float* decay_logit, int dir, int h) { const float x = decay_logit[dir * 8 + h]; return -log1pf(expf(-x)) * LOG2E; }
__device__ __forceinline__ int slot_row0(int b, int slot) { return slot < 2 ? NLAT + b * CTXL + slot * 128 : b * SEQ + (slot - 2) * 128; }

__device__ __forceinline__ void r1_task(LAS unsigned char* lds, int task, const bf16_t* Kg, const bf16_t* Vg, bf16_t* KVS, const float* decay_logit) {
    int tid = threadIdx.x; asm volatile("" : "+v"(tid));
    const int lane = tid & 63, w = tid >> 6, g = lane >> 4, r16 = lane & 15;
    const int bh = task / NSLOT, slot = task - bh * NSLOT, b = bh >> 3, h = bh & 7, row0 = slot_row0(b, slot);
    const float l2f = log2_gamma(decay_logit, 0, h), l2b = log2_gamma(decay_logit, 1, h);
    LAS unsigned char* VS = lds; LAS unsigned char* KF = lds + 67584; LAS unsigned char* KB = lds + 67584 + 34816;
#pragma unroll
    for (int it = 0; it < 8; ++it) { const int p = tid + it * 512, r = p >> 5, cc = p & 31; *(LAS u32x4*)(VS + r * 528 + cc * 16) = *(const u32x4*)(Vg + (size_t)(row0 + r) * DM + h * 256 + cc * 8); }
#pragma unroll
    for (int it = 0; it < 4; ++it) { const int p = tid + it * 512, r = p >> 4, cc = p & 15; const u32x4 kv = *(const u32x4*)(Kg + (size_t)(row0 + r) * 1024 + h * 128 + cc * 8);
        const float wf = __builtin_amdgcn_exp2f(l2f * (float)(127 - r)), wb = __builtin_amdgcn_exp2f(l2b * (float)r);
        u32x4 of, ob;
        of.x = pk2(bflo(kv.x) * wf, bfhi(kv.x) * wf); of.y = pk2(bflo(kv.y) * wf, bfhi(kv.y) * wf); of.z = pk2(bflo(kv.z) * wf, bfhi(kv.z) * wf); of.w = pk2(bflo(kv.w) * wf, bfhi(kv.w) * wf);
        ob.x = pk2(bflo(kv.x) * wb, bfhi(kv.x) * wb); ob.y = pk2(bflo(kv.y) * wb, bfhi(kv.y) * wb); ob.z = pk2(bflo(kv.z) * wb, bfhi(kv.z) * wb); ob.w = pk2(bflo(kv.w) * wb, bfhi(kv.w) * wb);
        *(LAS u32x4*)(KF + r * 272 + cc * 16) = of; *(LAS u32x4*)(KB + r * 272 + cc * 16) = ob; }
    __syncthreads();
#pragma unroll 1
    for (int dir = 0; dir < 2; ++dir) {
        const LAS unsigned char* KW = dir == 0 ? KF : KB;
        f32x4 af[8][2];
#pragma unroll
        for (int mb = 0; mb < 8; ++mb)
#pragma unroll
            for (int nb = 0; nb < 2; ++nb) af[mb][nb] = (f32x4){0.f, 0.f, 0.f, 0.f};
#pragma unroll
        for (int ks = 0; ks < 4; ++ks) {
            bf16x8 bv[2];
#pragma unroll
            for (int nb = 0; nb < 2; ++nb) bv[nb] = lds_tr8(VS, 528, 32 * ks, 32 * w + 16 * nb, lane);
#pragma unroll
            for (int mb = 0; mb < 8; ++mb) { const bf16x8 kf = lds_tr8(KW, 272, 32 * ks, 16 * mb, lane);
#pragma unroll
                for (int nb = 0; nb < 2; ++nb) af[mb][nb] = __builtin_amdgcn_mfma_f32_16x16x32_bf16(kf, bv[nb], af[mb][nb], 0, 0, 0); }
            __builtin_amdgcn_sched_barrier(0);
        }
        bf16_t* of_ = KVS + ((size_t)(bh * NSLOT + slot) * 2 + dir) * 32768;
#pragma unroll
        for (int mb = 0; mb < 8; ++mb)
#pragma unroll
            for (int nb = 0; nb < 2; ++nb) { const int e = 32 * w + 16 * nb + r16, d = 16 * mb + 4 * g; u32x2 o;
                o.x = pk2(af[mb][nb][0], af[mb][nb][1]); o.y = pk2(af[mb][nb][2], af[mb][nb][3]); *(u32x2*)(of_ + e * 128 + d) = o; }
    }
    __syncthreads();
}

__device__ __forceinline__ void r3_task(LAS unsigned char* lds, int task, const bf16_t* Qg, const bf16_t* Kg, const bf16_t* Vg, const bf16_t* KVS, const bf16_t* Gs, bf16_t* ZA, const float* decay_logit) {
    int tid = threadIdx.x; asm volatile("" : "+v"(tid));
    const int lane = tid & 63, w = tid >> 6, g = lane >> 4, r16 = lane & 15;
    const int bh = task >> 5, c = task & 31, b = bh >> 3, h = bh & 7, row0 = b * SEQ + c * 128;
    const float l2f = log2_gamma(decay_logit, 0, h), l2b = log2_gamma(decay_logit, 1, h);
    LAS unsigned char* QS = lds; LAS unsigned char* KS = lds + 34816; LAS unsigned char* CS = lds + 69632;
#pragma unroll
    for (int it = 0; it < 4; ++it) { const int p = tid + it * 512, r = p >> 4, cc = p & 15;
        *(LAS u32x4*)(QS + r * 272 + cc * 16) = *(const u32x4*)(Qg + (size_t)(row0 + r) * 1024 + h * 128 + cc * 8);
        *(LAS u32x4*)(KS + r * 272 + cc * 16) = *(const u32x4*)(Kg + (size_t)(row0 + r) * 1024 + h * 128 + cc * 8); }
#pragma unroll
    for (int it = 0; it < 8; ++it) { const int p = tid + it * 512, r = p >> 5, cc = p & 31; *(LAS u32x4*)(CS + r * 528 + cc * 16) = *(const u32x4*)(Vg + (size_t)(row0 + r) * DM + h * 256 + cc * 8); }
    __syncthreads();
    f32x4 pa[8];
#pragma unroll
    for (int mb = 0; mb < 8; ++mb) pa[mb] = (f32x4){0.f, 0.f, 0.f, 0.f};
    bf16x8 qf[4];
#pragma unroll
    for (int ks = 0; ks < 4; ++ks) qf[ks] = *(const LAS bf16x8*)(QS + (16 * w + r16) * 272 + (32 * ks + 8 * g) * 2);
#pragma unroll
    for (int ks = 0; ks < 4; ++ks)
#pragma unroll
        for (int mb = 0; mb < 8; ++mb) { const bf16x8 kf = *(const LAS bf16x8*)(KS + (16 * mb + r16) * 272 + (32 * ks + 8 * g) * 2); pa[mb] = __builtin_amdgcn_mfma_f32_16x16x32_bf16(kf, qf[ks], pa[mb], 0, 0, 0); }
    {   const int i = 16 * w + r16;
#pragma unroll
        for (int mb = 0; mb < 8; ++mb)
#pragma unroll
            for (int jj = 0; jj < 4; ++jj) { const int j = 16 * mb + 4 * g + jj; const int dd = i - j;
                const float f = dd > 0 ? __builtin_amdgcn_exp2f(l2f * (float)dd) : (dd < 0 ? __builtin_amdgcn_exp2f(l2b * (float)(-dd)) : 2.0f); pa[mb][jj] *= f; }
    }
    __syncthreads();
#pragma unroll
    for (int mb = 0; mb < 8; ++mb) { u32x2 o; o.x = pk2(pa[mb][0], pa[mb][1]); o.y = pk2(pa[mb][2], pa[mb][3]); *(LAS u32x2*)(KS + (16 * w + r16) * 272 + (16 * mb + 4 * g) * 2) = o; }
    LDS_WAIT(); asm volatile("" ::: "memory");
    f32x4 acc[16];
#pragma unroll
    for (int nb = 0; nb < 16; ++nb) acc[nb] = (f32x4){0.f, 0.f, 0.f, 0.f};
#pragma unroll
    for (int ks = 0; ks < 4; ++ks) { const bf16x8 pf = *(const LAS bf16x8*)(KS + (16 * w + r16) * 272 + (32 * ks + 8 * g) * 2);
#pragma unroll
        for (int nb = 0; nb < 16; ++nb) { const bf16x8 vf = lds_tr8(CS, 528, 32 * ks, 16 * nb, lane); acc[nb] = __builtin_amdgcn_mfma_f32_16x16x32_bf16(pf, vf, acc[nb], 0, 0, 0); if ((nb & 3) == 3) __builtin_amdgcn_sched_barrier(0); } }
#pragma unroll 1
    for (int dir = 0; dir < 2; ++dir) {
        __syncthreads();
        const bf16_t* Sg = KVS + ((size_t)(bh * NSLOT + c + 2) * 2 + dir) * 32768;
#pragma unroll
        for (int it = 0; it < 8; ++it) { const int p = tid + it * 512, r = p >> 4, cc = p & 15; *(LAS u32x4*)(CS + r * 272 + cc * 16) = *(const u32x4*)(Sg + (size_t)r * 128 + cc * 8); }
        __syncthreads();
        const int ia = 16 * w + r16; const float sf = dir == 0 ? __builtin_amdgcn_exp2f(l2f * (float)(ia + 1)) : __builtin_amdgcn_exp2f(l2b * (float)(128 - ia));
#pragma unroll
        for (int ks = 0; ks < 4; ++ks) { bf16x8 qs; const bf16x8 q0 = *(const LAS bf16x8*)(QS + (16 * w + r16) * 272 + (32 * ks + 8 * g) * 2);
#pragma unroll
            for (int e = 0; e < 8; e += 2) { const unsigned pk = pk2(bf1(q0[e]) * sf, bf1(q0[e + 1]) * sf); qs[e] = (short)(pk & 0xffffu); qs[e + 1] = (short)(pk >> 16); }
#pragma unroll
            for (int nb = 0; nb < 16; ++nb) { const bf16x8 sfr = *(const LAS bf16x8*)(CS + (16 * nb + r16) * 272 + (32 * ks + 8 * g) * 2); acc[nb] = __builtin_amdgcn_mfma_f32_16x16x32_bf16(qs, sfr, acc[nb], 0, 0, 0); if ((nb & 3) == 3) __builtin_amdgcn_sched_barrier(0); } }
    }
#pragma unroll
    for (int jj = 0; jj < 4; ++jj) {
        float s = 0.f;
#pragma unroll
        for (int nb = 0; nb < 16; ++nb) s += acc[nb][jj];
        s += __shfl_xor(s, 1); s += __shfl_xor(s, 2); s += __shfl_xor(s, 4); s += __shfl_xor(s, 8);
        const float mu = s * (1.0f / 256.0f); float q = 0.f;
#pragma unroll
        for (int nb = 0; nb < 16; ++nb) { const float d = acc[nb][jj] - mu; q += d * d; }
        q += __shfl_xor(q, 1); q += __shfl_xor(q, 2); q += __shfl_xor(q, 4); q += __shfl_xor(q, 8);
        const float rstd = 1.0f / sqrtf(q * (1.0f / 256.0f) + 1e-5f);
        const size_t ro = (size_t)(row0 + 16 * w + 4 * g + jj) * DM + h * 256 + r16, zo = (size_t)(row0 + 16 * w + 4 * g + jj) * 3072 + h * 256 + r16;
#pragma unroll
        for (int nb = 0; nb < 16; ++nb) { const float gs = __builtin_bit_cast(float, ((unsigned)Gs[ro + 16 * nb]) << 16); ZA[zo + 16 * nb] = (bf16_t)f2bf(gs * (acc[nb][jj] - mu) * rstd); }
    }
    __syncthreads();
}

__global__ void __launch_bounds__(512, 2) fwd_megakernel(Args args) {
    extern __shared__ __attribute__((aligned(16))) unsigned char lds_raw[];
    LAS unsigned char* lds = (LAS unsigned char*)lds_raw;
    cg::grid_group grid = cg::this_grid();
    const int tid = threadIdx.x, lane = tid & 63, wave = __builtin_amdgcn_readfirstlane(tid >> 6);
    const int G = gridDim.x, bx = blockIdx.x;
    const int gw = bx * 8 + wave, NGW = G * 8;
    unsigned char* ws = args.ws;
    const float* x = args.in[0]; const float* cvec = args.in[1]; const float* ctx = args.in[2]; const float* cctx = args.in[3];
    const float* w_ada = args.in[4]; const float* b_ada = args.in[5]; const float* norm_g = args.in[6];
    const float* decay_logit = args.in[12]; const float* pool_scale = args.in[14]; const float* b_gate = args.in[18]; const float* final_g = args.in[20];
    float* out = args.out;
    float* MOD = (float*)(ws + WS_MOD); float* ROPE = (float*)(ws + WS_ROPE);
    bf16_t* W13A = (bf16_t*)(ws + WS_W13A); bf16_t* W2A = (bf16_t*)(ws + WS_W2A); bf16_t* W13B = (bf16_t*)(ws + WS_W13B); bf16_t* W2B = (bf16_t*)(ws + WS_W2B);
    bf16_t* WIN = (bf16_t*)(ws + WS_WIN); bf16_t* WOA = (bf16_t*)(ws + WS_WOA); bf16_t* WOB = (bf16_t*)(ws + WS_WOB); bf16_t* WOUT = (bf16_t*)(ws + WS_WOUT); bf16_t* POOLW = (bf16_t*)(ws + WS_POOLW);
    bf16_t* AN = (bf16_t*)(ws + WS_AN); bf16_t* H = (bf16_t*)(ws + WS_H); float* HC1 = (float*)(ws + WS_HC1);
    bf16_t* Kb = (bf16_t*)(ws + WS_K); bf16_t* Qb = (bf16_t*)(ws + WS_Q); bf16_t* Vb = (bf16_t*)(ws + WS_V); bf16_t* Gb = (bf16_t*)(ws + WS_G); bf16_t* PIN = (bf16_t*)(ws + WS_PIN);
    bf16_t* GA = (bf16_t*)(ws + WS_GA); bf16_t* GB = (bf16_t*)(ws + WS_GB); bf16_t* POOLED = (bf16_t*)(ws + WS_POOLED); bf16_t* PM = (bf16_t*)(ws + WS_PM);
    bf16_t* KVS = (bf16_t*)(ws + WS_H + 26 * MiB); bf16_t* ZA = AN; bf16_t* MMb = Gb;

#ifdef PROBE_A
    unsigned long long t_probe0 = 0, t_probe1 = 0;
#define PSTAMP(k, var) do { if ((k) == PROBE_A) var = __builtin_amdgcn_s_memrealtime(); } while (0)
#define PSTAMP2(k, var) do { if ((k) == PROBE_B) var = __builtin_amdgcn_s_memrealtime(); } while (0)
#else
#define PSTAMP(k, var) do {} while (0)
#define PSTAMP2(k, var) do {} while (0)
#endif
    volatile LAS unsigned* xst = (volatile LAS unsigned*)(lds + LDS_BYTES - 64);
    if (tid < 2) xst[tid] = 0u;
    __syncthreads();
    const XcdBarrier xbar = xcd_barrier_post((unsigned*)(ws + WS_BAR), xst);
    if (args.pad0 == 0x5a5a5a5a) grid.sync();
    PSTAMP(0, t_probe0); PSTAMP2(0, t_probe1);
    {
        LAS float* scr = (LAS float*)(lds + wave * 16640);
        constexpr int I_13 = 32 * 176, I_2 = 88 * 32, I_IN = 32 * 112, I_GT = 32 * 64, I_OA = 32 * 32, I_OB = 16 * 32, I_OUT = 32 * 32, I_PW = 16;
        constexpr int NIT = 2 * I_13 + 2 * I_2 + I_IN + I_GT + I_OA + I_OB + I_OUT + 4 * I_PW;
        for (int it = gw; it < NIT; it += NGW) {
            int r = it;
            if (r < I_13) { tr_item(args.in[7], DM, 2 * DFF, W13A, 0, 1, scr, r, lane); continue; } r -= I_13;
            if (r < I_13) { tr_item(args.in[9], DM, 2 * DFF, W13B, 0, 1, scr, r, lane); continue; } r -= I_13;
            if (r < I_2) { tr_item(args.in[8], DFF, DM, W2A, 0, 0, scr, r, lane); continue; } r -= I_2;
            if (r < I_2) { tr_item(args.in[10], DFF, DM, W2B, 0, 0, scr, r, lane); continue; } r -= I_2;
            if (r < I_IN) { tr_item(args.in[11], DM, 7168, WIN, 0, 2, scr, r, lane); continue; } r -= I_IN;
            if (r < I_GT) { tr_item(args.in[17], DM, 4096, WIN, 7168, 3, scr, r, lane); continue; } r -= I_GT;
            if (r < I_OA) { tr_item(args.in[15], DM, DM, WOA, 0, 0, scr, r, lane, 3072, 0); continue; } r -= I_OA;
            if (r < I_OB) { tr_item(args.in[16], 1024, DM, WOA, 0, 0, scr, r, lane, 3072, 2048); continue; } r -= I_OB;
            if (r < I_OUT) { tr_item(args.in[19], DM, DM, WOUT, 0, 0, scr, r, lane); continue; } r -= I_OUT;
            { const int gp = r >> 4; tr_item(args.in[13] + (size_t)gp * 65536, 256, 256, POOLW + (size_t)gp * 65536, 0, 0, scr, r & 15, lane); }
        }
        __syncthreads();
        for (int it = bx; it < 72 * 4; it += G) {
            const int cgp = it % 72, kq = it / 72, col = cgp * 256 + lane * 4, kb = kq * 512 + wave * 64, k = kb + lane;
            const float s0 = fsilu(cvec[k]), s1 = fsilu(cvec[DM + k]), s2 = fsilu(cctx[k]);
            f32x4 a0 = {0.f, 0.f, 0.f, 0.f}, a1 = a0, a2 = a0;
#pragma unroll 16
            for (int kk = 0; kk < 64; ++kk) { const f32x4 wv = *(const f32x4*)(w_ada + (size_t)(kb + kk) * NMOD + col);
                a0 += wv * __shfl(s0, kk); a1 += wv * __shfl(s1, kk); a2 += wv * __shfl(s2, kk); }
            LAS f32x4* red = (LAS f32x4*)lds;
            red[(wave * 3 + 0) * 64 + lane] = a0; red[(wave * 3 + 1) * 64 + lane] = a1; red[(wave * 3 + 2) * 64 + lane] = a2;
            __syncthreads();
            if (tid < 192) { const int rr = tid >> 6; f32x4 t = red[rr * 64 + lane];
#pragma unroll
                for (int w8 = 1; w8 < 8; ++w8) t += red[(w8 * 3 + rr) * 64 + lane];
                if (kq == 0) t += *(const f32x4*)(b_ada + col);
#pragma unroll
                for (int e = 0; e < 4; ++e) __hip_atomic_fetch_add(MOD + rr * NMOD + col + e, t[e], __ATOMIC_RELAXED, __HIP_MEMORY_SCOPE_AGENT); }
            __syncthreads();
        }
        { const int id = bx * 512 + tid; if (id < 2048) { const int pos = id >> 5, i = id & 31; const float inv = powf(10000.0f, -(float)i * (1.0f / 32.0f)); const float ang = (float)pos * inv; ROPE[2 * id] = cosf(ang); ROPE[2 * id + 1] = sinf(ang); } }
    }
    GRID_SYNC();
#if defined(STOP) && STOP == 100
    for (size_t i = (size_t)bx * 512 + tid; i < (size_t)NLAT * DM; i += (size_t)G * 512) out[i] = bf1((short)WIN[i]) + (i + (size_t)NLAT * DM < (size_t)11264 * 2048 ? bf1((short)WIN[i + (size_t)NLAT * DM]) : 0.f);
    return;
#endif
    PSTAMP(1, t_probe0); PSTAMP2(1, t_probe1);
    norm_rows(x, norm_g, MOD, 0, 1, AN, gw, NGW, lane);
    norm_ctx_rows(ctx, norm_g, MOD, 0, 1, AN, gw, NGW, lane, ctx, 0);
    GRID_SYNC();
    PSTAMP(2, t_probe0); PSTAMP2(2, t_probe1);
    { pg8::Gemm g{AN, W13A, DM, DM}; pg8::MixOrder S; S.init(32, 44, 2, 44, G, bx, 32); pg8::EpiSwiglu E{H, DFF}; pg8::gemm_phase<pg8::EpiSwiglu, pg8::MixOrder, true>(lds, g, S, E); }
    GRID_SYNC();
    PSTAMP(3, t_probe0); PSTAMP2(3, t_probe1);
    { pg8::Gemm g{H, W2A, DFF, DFF}; pg8::MixOrder S; S.init(32, 8, 2, 8, G, bx, 88, 11); pg8::EpiResid E{x, out, (float*)(ws + WS_K), MOD, 2, 0.5f}; pg8::gemm_phase<pg8::EpiResid, pg8::MixOrder, true>(lds, g, S, E); }
    GRID_SYNC();
#if defined(STOP) && STOP == 3
    return;
#endif
    PSTAMP(4, t_probe0); PSTAMP2(4, t_probe1);
    norm_rows(out, norm_g + DM, MOD, 3, 4, AN, gw, NGW, lane);
    norm_ctx_rows(ctx, norm_g + DM, MOD, 3, 4, AN, gw, NGW, lane, (const float*)(ws + WS_K), 11);
    GRID_SYNC();
#if defined(STOP) && STOP == 4
    for (size_t i = (size_t)bx * 512 + tid; i < (size_t)NLAT * DM; i += (size_t)G * 512) out[i] = bf1((short)AN[i]) + ((i >> 11) < 512 ? bf1((short)AN[i + (size_t)NLAT * DM]) : 0.f);
    return;
#endif
    PSTAMP(5, t_probe0); PSTAMP2(5, t_probe1);
    { pg8::Gemm g{AN, WIN, DM, DM}; pg8::MixOrder S; S.init(32, 44, 2, 12, G, bx, 32); pg8::EpiIn E{Kb, Qb, Vb, Gb, PIN, GA, GB, b_gate, ROPE}; pg8::gemm_phase<pg8::EpiIn, pg8::MixOrder, true>(lds, g, S, E); }
    GRID_SYNC();
#if defined(STOP) && STOP == 5
    for (size_t i = (size_t)bx * 512 + tid; i < (size_t)NLAT * DM; i += (size_t)G * 512) { const size_t r = i >> 11, c = i & 2047; out[i] = bf1((short)Kb[r * 1024 + (c & 1023)]) + bf1((short)Qb[r * 1024 + (c & 1023)]) + bf1((short)Vb[i]) + bf1((short)Gb[i]) + bf1((short)PIN[r * 1024 + (c & 1023)]) + bf1((short)GA[i]) + bf1((short)GB[i]); }
    return;
#endif
    PSTAMP(6, t_probe0); PSTAMP2(6, t_probe1);
    for (int t = bx; t < 16 * NSLOT; t += G) r1_task(lds, t, Kb, Vb, KVS, decay_logit);
    for (int it = bx * 512 + tid; it < NLAT * 128; it += G * 512) {
        const int r = it >> 7, pc = it & 127, gp = pc >> 5, win = 2 << gp, lo = win >> 1, hi = win - 1 - lo, t = r & (SEQ - 1), rb = r - t;
        const int st = t - lo < 0 ? 0 : t - lo, en = t + hi + 1 > SEQ ? SEQ : t + hi + 1;
        float s[8] = {0.f, 0.f, 0.f, 0.f, 0.f, 0.f, 0.f, 0.f};
        for (int q = st; q < en; ++q) { const u32x4 v = *(const u32x4*)(PIN + (size_t)(rb + q) * 1024 + pc * 8);
            s[0] += bflo(v.x); s[1] += bfhi(v.x); s[2] += bflo(v.y); s[3] += bfhi(v.y); s[4] += bflo(v.z); s[5] += bfhi(v.z); s[6] += bflo(v.w); s[7] += bfhi(v.w); }
        const float ic = 1.0f / (float)(en - st); const u32x4 v = *(const u32x4*)(PIN + (size_t)r * 1024 + pc * 8);
        u32x4 o; o.x = pk2(s[0] * ic - bflo(v.x), s[1] * ic - bfhi(v.x)); o.y = pk2(s[2] * ic - bflo(v.y), s[3] * ic - bfhi(v.y)); o.z = pk2(s[4] * ic - bflo(v.z), s[5] * ic - bfhi(v.z)); o.w = pk2(s[6] * ic - bflo(v.w), s[7] * ic - bfhi(v.w));
        *(u32x4*)(POOLED + (size_t)r * 1024 + pc * 8) = o;
    }
    GRID_SYNC();
    PSTAMP(7, t_probe0); PSTAMP2(7, t_probe1);
    for (int id = bx * 512 + tid; id < 16 * 2 * 4096; id += G * 512) {
        const int bh = id >> 13, dir = (id >> 12) & 1, off = (id & 4095) * 8, h = bh & 7;
        const float cd = __builtin_amdgcn_exp2f(log2_gamma(decay_logit, dir, h) * 128.0f);
        bf16_t* base = KVS + (size_t)bh * NSLOT * 65536 + dir * 32768 + off;
        float r[8] = {0.f, 0.f, 0.f, 0.f, 0.f, 0.f, 0.f, 0.f};
#pragma unroll 2
        for (int s = 0; s < NSLOT; ++s) {
            const int slot = dir == 0 ? s : (s == 0 ? 1 : (s == 1 ? 0 : NSLOT + 1 - s));
            u32x4* p = (u32x4*)(base + (size_t)slot * 65536); const u32x4 v = *p;
            u32x4 o; o.x = pk2(r[0], r[1]); o.y = pk2(r[2], r[3]); o.z = pk2(r[4], r[5]); o.w = pk2(r[6], r[7]); *p = o;
            r[0] = r[0] * cd + bflo(v.x); r[1] = r[1] * cd + bfhi(v.x); r[2] = r[2] * cd + bflo(v.y); r[3] = r[3] * cd + bfhi(v.y);
            r[4] = r[4] * cd + bflo(v.z); r[5] = r[5] * cd + bfhi(v.z); r[6] = r[6] * cd + bflo(v.w); r[7] = r[7] * cd + bfhi(v.w);
        }
    }
    { const int gp = (bx >> 5) & 3; pg8::Gemm g{POOLED + gp * 256, POOLW + (size_t)gp * 65536, 1024, 256}; pg8::MixOrder S; S.init(32, 1, 0, 1, 1 << 20, bx < 128 ? (bx & 31) : 32, 4);
        pg8::EpiPool E{ZA, pool_scale, gp}; pg8::gemm_phase<pg8::EpiPool, pg8::MixOrder, true>(lds, g, S, E); }
    GRID_SYNC();
#if defined(STOP) && STOP == 7
    for (size_t i = (size_t)bx * 512 + tid; i < (size_t)NLAT * DM; i += (size_t)G * 512) { const size_t r = i >> 11, c = i & 2047; out[i] = bf1((short)POOLED[r * 1024 + (c & 1023)]) + 0.f + bf1((short)KVS[i]) + bf1((short)KVS[i + (size_t)NLAT * DM]); }
    return;
#endif
    PSTAMP(8, t_probe0); PSTAMP2(8, t_probe1);
    for (int t = bx; t < 512; t += G) r3_task(lds, t, Qb, Kb, Vb, KVS, Gb, ZA, decay_logit);
    GRID_SYNC();
#if defined(STOP) && STOP == 8
    for (size_t i = (size_t)bx * 512 + tid; i < (size_t)NLAT * DM; i += (size_t)G * 512) out[i] = bf1((short)ZA[i]);
    return;
#endif
    PSTAMP(9, t_probe0); PSTAMP2(9, t_probe1);
    { pg8::Gemm g{ZA, WOA, 3072, 3072}; pg8::MixOrder S; S.init(32, 8, 0, 1, G, bx, 48); pg8::EpiMerge E{GA, GB, MMb, 32}; pg8::gemm_phase<pg8::EpiMerge, pg8::MixOrder, true>(lds, g, S, E); }
    GRID_SYNC();
#if defined(STOP) && STOP == 9
    for (size_t i = (size_t)bx * 512 + tid; i < (size_t)NLAT * DM; i += (size_t)G * 512) out[i] = bf1((short)MMb[i]);
    return;
#endif
    PSTAMP(10, t_probe0); PSTAMP2(10, t_probe1);
    { pg8::Gemm g{MMb, WOUT, DM, DM}; pg8::MixOrder S; S.init(32, 8, 0, 1, G, bx, 32); pg8::EpiResid E{out, out, out, MOD, 5, 1.0f}; pg8::gemm_phase<pg8::EpiResid, pg8::MixOrder, true>(lds, g, S, E); }
    GRID_SYNC();
    PSTAMP(11, t_probe0); PSTAMP2(11, t_probe1);
    norm_rows(out, norm_g + 2 * DM, MOD, 6, 7, AN, gw, NGW, lane);
    GRID_SYNC();
    PSTAMP(12, t_probe0); PSTAMP2(12, t_probe1);
    { pg8::Gemm g{AN, W13B, DM, DM}; pg8::MixOrder S; S.init(32, 44, 0, 1, G, bx, 32); pg8::EpiSwiglu E{H, DFF}; pg8::gemm_phase<pg8::EpiSwiglu, pg8::MixOrder, true>(lds, g, S, E); }
    GRID_SYNC();
    PSTAMP(13, t_probe0); PSTAMP2(13, t_probe1);
    { pg8::Gemm g{H, W2B, DFF, DFF}; pg8::MixOrder S; S.init(32, 8, 0, 1, G, bx, 88); pg8::EpiResid E{out, out, out, MOD, 8, 0.5f}; pg8::gemm_phase<pg8::EpiResid, pg8::MixOrder, true>(lds, g, S, E); }
    GRID_SYNC();
    PSTAMP(14, t_probe0); PSTAMP2(14, t_probe1);
    for (int r = gw; r < NLAT; r += 2 * NGW) {
        f32x4* a4 = (f32x4*)(out + (size_t)r * DM) + lane; f32x4* b4 = (f32x4*)(out + (size_t)(r + NGW) * DM) + lane;
        f32x4 va[8], vb[8]; float sa = 0.f, sb = 0.f;
#pragma unroll
        for (int j = 0; j < 8; ++j) { va[j] = a4[64 * j]; vb[j] = b4[64 * j]; }
#pragma unroll
        for (int j = 0; j < 8; ++j) { sa += (va[j][0] * va[j][0] + va[j][1] * va[j][1]) + (va[j][2] * va[j][2] + va[j][3] * va[j][3]); sb += (vb[j][0] * vb[j][0] + vb[j][1] * vb[j][1]) + (vb[j][2] * vb[j][2] + vb[j][3] * vb[j][3]); }
#pragma unroll
        for (int o = 1; o < 64; o <<= 1) { sa += __shfl_xor(sa, o); sb += __shfl_xor(sb, o); }
        const float rsa = 1.0f / sqrtf(sa * (1.0f / DM) + 1e-6f), rsb = 1.0f / sqrtf(sb * (1.0f / DM) + 1e-6f);
        const f32x4* g4 = (const f32x4*)final_g + lane;
#pragma unroll
        for (int j = 0; j < 8; ++j) { const f32x4 gg = g4[64 * j]; a4[64 * j] = va[j] * rsa * gg; b4[64 * j] = vb[j] * rsb * gg; }
    }
#ifdef PROBE_A
    PSTAMP2(15, t_probe1);
    GRID_SYNC();
    if (bx == 0) { const unsigned long long dt = __shfl(t_probe1 - t_probe0, 0); const int n = (int)(dt / PDIV); for (int i = tid; i < n && i < 14000; i += 512) out[(size_t)i * 97 + 5] += 0.15f; }
#endif
}

extern "C" void kernel_launch(void* const* d_in, const int* in_sizes, int n_in, void* d_out, int out_size, void* d_ws, size_t ws_size, hipStream_t stream) {
    static int grid = 0;
    if (grid == 0) {
        if (n_in != 21 || out_size != NLAT * DM || ws_size < WS_END) { fprintf(stderr, "kernel_launch: unexpected shapes (n_in %d out %d ws %zu need %zu)\n", n_in, out_size, ws_size, (size_t)WS_END); grid = -1; return; }
        int dev = 0, cus = 0, per_cu = 0;
        (void)hipGetDevice(&dev);
        (void)hipDeviceGetAttribute(&cus, hipDeviceAttributeMultiprocessorCount, dev);
        (void)hipFuncSetAttribute((const void*)fwd_megakernel, hipFuncAttributeMaxDynamicSharedMemorySize, LDS_BYTES);
        (void)hipOccupancyMaxActiveBlocksPerMultiprocessor(&per_cu, (const void*)fwd_megakernel, 512, LDS_BYTES);
        (void)hipGetLastError();
        if (per_cu < 1) fprintf(stderr, "kernel_launch: occupancy query says %d blocks per CU\n", per_cu);
        grid = cus;
    }
    if (grid < 0) return;
    (void)hipMemsetAsync((char*)d_ws, 0, 512 * 1024, stream);
    Args a{};
    for (int i = 0; i < 21; ++i) a.in[i] = (const float*)d_in[i];
    a.out = (float*)d_out; a.ws = (unsigned char*)d_ws;
    void* kargs[] = {&a};
    hipError_t e = hipLaunchCooperativeKernel((const void*)fwd_megakernel, dim3(grid), dim3(512), kargs, LDS_BYTES, stream);
    if (e != hipSuccess) fprintf(stderr, "cooperative launch failed: %s (grid %d)\n", hipGetErrorString(e), grid);
}
```
